# Optimizing an MI355X kernel written in HIP

```python
import jax, jax.numpy as jnp
from jax import lax
import numpy as np

D_MODEL = 1024
BATCH = 8
SEQ = 2048
DEPTH = 2
DEC_BATCH = 32
DEC_SEQ = 4
PAST_LEN = 8192
PAGE_SIZE = 128

NSA_HEADS = 8
NSA_KV_HEADS = 2
NSA_HEAD_DIM = 64
CMP_STRIDE = 16
CMP_BLOCK = 32
CMP_RATIO = CMP_BLOCK // CMP_STRIDE
CMP_HIDDEN = 64
SEL_BLOCK = 64
N_SEL = 16
WINDOW = 512
NSA_QBLK = 64
RET_HEADS = 4
RET_DK = 128
RET_DV = 256
RET_CHUNK = 128
ROPE_BASE = 10000.0
D_FF = 2816
CONV_W = 3
RMS_EPS = 1e-6
GN_EPS = 1e-5
NEG = -1e30
FORCE_BONUS = 1e4

A_Q = NSA_HEADS * NSA_HEAD_DIM
A_KV = 3 * 2 * NSA_KV_HEADS * NSA_HEAD_DIM
A_G = 3 * NSA_HEADS
B_QK = RET_HEADS * RET_DK
B_V = RET_HEADS * RET_DV
IN_SPLITS = (A_Q, A_KV, A_G, B_QK, B_QK, B_V, B_V, D_MODEL, D_MODEL)
N_IN = A_Q + A_KV + A_G + 2 * B_QK + 2 * B_V + 2 * D_MODEL

kernel_name = 'nsa_retention_convffn_hybrid_step'


def split_points():
    pts, acc = [], 0
    for s in IN_SPLITS[:-1]:
        acc += s
        pts.append(acc)
    return pts


def rmsnorm(x, w):
    xf = x.astype(jnp.float32)
    y = xf * lax.rsqrt(jnp.mean(xf * xf, axis=-1, keepdims=True) + RMS_EPS)
    return (y * w.astype(jnp.float32)).astype(x.dtype)


def rotary(x, pos):
    half = x.shape[-1] // 2
    inv = jnp.exp(-jnp.log(ROPE_BASE) * jnp.arange(half, dtype=jnp.float32) / half)
    ang = pos.astype(jnp.float32)[:, None] * inv[None, :]
    cos = jnp.cos(ang)[None, :, None, :]
    sin = jnp.sin(ang)[None, :, None, :]
    xf = x.astype(jnp.float32)
    x1, x2 = xf[..., :half], xf[..., half:]
    return jnp.concatenate([x1 * cos - x2 * sin, x1 * sin + x2 * cos], axis=-1).astype(x.dtype)


def gather_pages(pool, page_table):
    g = pool[page_table]
    return g.reshape(g.shape[0], g.shape[1] * g.shape[2], *g.shape[3:])


def keep_last(rows, n):
    t = rows.shape[1]
    if t >= n:
        return rows[:, t - n:]
    return jnp.pad(rows, ((0, 0), (n - t, 0)) + ((0, 0),) * (rows.ndim - 2))


def compress_kv(kv, cmp_pos, cmp_w1, cmp_w2):
    B, L, _, G, dh = kv.shape
    n_chunk = L // CMP_STRIDE
    n_cmp = n_chunk - CMP_RATIO + 1
    chunks = kv[:, :n_chunk * CMP_STRIDE].reshape(B, n_chunk, CMP_STRIDE, 2, G, dh)
    w1 = cmp_w1.reshape(2, CMP_RATIO, CMP_STRIDE, dh, CMP_HIDDEN)
    bias = jnp.einsum('eld,eldh->eh', cmp_pos, cmp_w1.reshape(2, CMP_BLOCK, dh, CMP_HIDDEN))
    hid = bias[None, None, :, None, :]
    for m in range(CMP_RATIO):
        hid = hid + jnp.einsum('bnsegd,esdh->bnegh', chunks[:, m:m + n_cmp], w1[:, m])
    return jnp.einsum('bnegh,ehd->bnegd', jax.nn.gelu(hid), cmp_w2)


def sel_overlap(n_cmp, n_sel):
    cs = jnp.arange(n_cmp) * CMP_STRIDE
    ss = jnp.arange(n_sel) * SEL_BLOCK
    ok = (cs[:, None] < ss[None, :] + SEL_BLOCK) & (cs[:, None] + CMP_BLOCK > ss[None, :])
    return ok.astype(jnp.float32)


def nsa_block(q, qpos, gates, kc, vc, cmp_end, overlap, ks_blk, vs_blk, kw, vw, kwpos):
    f32 = jnp.float32
    B, Tb, H, dh = q.shape
    G = kc.shape[2]
    scale = dh ** -0.5
    qg = q.reshape(B, Tb, G, H // G, dh)
    s_c = jnp.einsum('btgqd,bngd->bgqtn', qg, kc).astype(f32) * scale
    c_ok = cmp_end[None, :] <= qpos[:, None]
    p_c = jnp.where(c_ok, jax.nn.softmax(jnp.where(c_ok, s_c, NEG), axis=-1), 0.0)
    o_c = jnp.einsum('bgqtn,bngd->btgqd', p_c.astype(vc.dtype), vc)
    imp = jnp.einsum('bgqtn,nj->bgtj', p_c, overlap)
    n_sel = ks_blk.shape[2]
    j = jnp.arange(n_sel)[None, :]
    cur = (qpos // SEL_BLOCK)[:, None]
    s_ok = j * SEL_BLOCK <= qpos[:, None]
    forced = (j == 0) | (j == cur) | (j == cur - 1)
    score = jnp.where(s_ok, imp + jnp.where(forced, FORCE_BONUS, 0.0), NEG)
    top_s, idx = lax.top_k(score, min(N_SEL, n_sel))
    take = jax.vmap(jax.vmap(lambda blk, ix: blk[ix]))
    k_s = take(ks_blk, idx)
    v_s = take(vs_blk, idx)
    tok = idx[..., None] * SEL_BLOCK + jnp.arange(SEL_BLOCK)
    t_ok = (top_s > 0.5 * NEG)[..., None] & (tok <= qpos[None, None, :, None, None])
    s_s = jnp.einsum('btgqd,bgtksd->bgqtks', qg, k_s).astype(f32) * scale
    s_s = jnp.where(t_ok[:, :, None], s_s, NEG)
    shp = s_s.shape
    p_s = jax.nn.softmax(s_s.reshape(*shp[:4], -1), axis=-1).reshape(shp)
    o_s = jnp.einsum('bgqtks,bgtksd->btgqd', p_s.astype(v_s.dtype), v_s)
    s_w = jnp.einsum('btgqd,bsgd->bgqts', qg, kw).astype(f32) * scale
    rel = qpos[:, None] - kwpos[None, :]
    w_ok = (rel >= 0) & (rel < WINDOW) & (kwpos[None, :] >= 0)
    p_w = jax.nn.softmax(jnp.where(w_ok, s_w, NEG), axis=-1)
    o_w = jnp.einsum('bgqts,bsgd->btgqd', p_w.astype(vw.dtype), vw)
    g = jax.nn.sigmoid(gates.astype(f32)).reshape(B, Tb, G, H // G, 3, 1).astype(q.dtype)
    o = g[..., 0, :] * o_c + g[..., 1, :] * o_s + g[..., 2, :] * o_w
    return o.reshape(B, Tb, H * dh)


def nsa_attention(q, gates, kv_cmp, kv_sel, kv_win, q_pos0, w_pos0, cmp_pos, cmp_w1, cmp_w2):
    B, Tq, H, dh = q.shape
    L = kv_cmp.shape[1]
    G = kv_cmp.shape[3]
    comp = compress_kv(kv_cmp, cmp_pos, cmp_w1, cmp_w2)
    kc, vc = comp[:, :, 0], comp[:, :, 1]
    n_cmp = comp.shape[1]
    cmp_end = jnp.arange(n_cmp) * CMP_STRIDE + (CMP_BLOCK - 1)
    n_sel = -(-L // SEL_BLOCK)
    overlap = sel_overlap(n_cmp, n_sel)
    kvs = jnp.pad(kv_sel, ((0, 0), (0, n_sel * SEL_BLOCK - L), (0, 0), (0, 0), (0, 0)))
    kvs = kvs.reshape(B, n_sel, SEL_BLOCK, 2, G, dh).transpose(3, 0, 4, 1, 2, 5)
    past_w = kv_win.shape[1] - Tq
    pad_n = max(WINDOW - past_w, 0)
    kvw = jnp.pad(kv_win, ((0, 0), (pad_n, 0), (0, 0), (0, 0), (0, 0)))
    base = past_w + pad_n - WINDOW
    kw_pos0 = w_pos0 - pad_n
    qb_len = NSA_QBLK if Tq % NSA_QBLK == 0 else Tq
    nb = Tq // qb_len
    qb = q.reshape(B, nb, qb_len, H, dh).swapaxes(0, 1)
    gb = gates.reshape(B, nb, qb_len, H, 3).swapaxes(0, 1)

    def one(args):
        i, q_i, g_i = args
        offs = i * qb_len
        qpos = q_pos0 + offs + jnp.arange(qb_len)
        start = base + offs
        w_i = lax.dynamic_slice_in_dim(kvw, start, WINDOW + qb_len, axis=1)
        kwpos = kw_pos0 + start + jnp.arange(WINDOW + qb_len)
        return nsa_block(q_i, qpos, g_i, kc, vc, cmp_end, overlap, kvs[0], kvs[1],
                         w_i[:, :, 0], w_i[:, :, 1], kwpos)

    out = lax.map(one, (jnp.arange(nb), qb, gb))
    return out.swapaxes(0, 1).reshape(B, Tq, H * dh)


def retention(q, k, v, state0):
    f32 = jnp.float32
    B, T, H, _ = q.shape
    dv = v.shape[-1]
    C = RET_CHUNK if T % RET_CHUNK == 0 else T
    n = T // C
    log_g = jnp.log(1.0 - jnp.exp2(-5.0 - jnp.arange(H, dtype=f32)))
    i = jnp.arange(C, dtype=f32)
    diff = i[:, None] - i[None, :]
    dmask = jnp.where(diff >= 0, jnp.exp(jnp.maximum(diff, 0.0)[None] * log_g[:, None, None]), 0.0)
    q_dec = jnp.exp((i + 1.0)[None, :] * log_g[:, None])[..., None]
    k_dec = jnp.exp((C - 1.0 - i)[None, :] * log_g[:, None])[..., None]
    s_dec = jnp.exp(C * log_g)[:, None, None]

    def chunks(a):
        return a.astype(f32).reshape(B, n, C, H, a.shape[-1]).transpose(1, 0, 3, 2, 4)

    def step(S, qkv):
        qc, kc, vc = qkv
        inner = jnp.einsum('bhcd,bhed->bhce', qc, kc) * dmask
        o = jnp.einsum('bhce,bhev->bhcv', inner, vc) + jnp.einsum('bhcd,bhdv->bhcv', qc * q_dec, S)
        S = S * s_dec + jnp.einsum('bhcd,bhcv->bhdv', kc * k_dec, vc)
        return S, o

    S, o = lax.scan(step, state0.astype(f32), (chunks(q), chunks(k), chunks(v)))
    return o.transpose(1, 0, 3, 2, 4).reshape(B, T, H, dv), S


def group_norm(o, w):
    mu = jnp.mean(o, axis=-1, keepdims=True)
    var = jnp.mean(jnp.square(o - mu), axis=-1, keepdims=True)
    return (o - mu) * lax.rsqrt(var + GN_EPS) * w.astype(jnp.float32)


def conv_ffn(h, prev, w_in, conv_w, conv_b, w_out):
    T = h.shape[1]
    a, b = jnp.split(h @ w_in, 2, axis=-1)
    a_ext = jnp.concatenate([prev.astype(a.dtype), a], axis=1)
    u = conv_b
    for j in range(CONV_W):
        u = u + a_ext[:, j:j + T] * conv_w[j]
    y = (jax.nn.gelu(u) * b) @ w_out
    return y, a_ext[:, T:]


def decoder_layer(x, c, pos0, past_cmp, past_sel, win_buf, ret_state, conv_prev, win_keep,
                  norm1_w, ada_w, ada_b, w_in, cmp_pos, cmp_w1, cmp_w2, w_oa, ret_gn_w, w_ob, w_o,
                  norm2_w, ffn_w_in, ffn_conv_w, ffn_conv_b, ffn_w_out):
    B, T, _ = x.shape
    mod = jax.nn.silu(c) @ ada_w + ada_b
    sh1, sc1, g1, sh2, sc2, g2 = jnp.split(mod[:, None, :], 6, axis=-1)
    h = rmsnorm(x, norm1_w) * (1 + sc1) + sh1
    aq, akv, ag, rq, rk, rv, rg, ga, gb = jnp.split(h @ w_in, split_points(), axis=-1)
    akv = akv.reshape(B, T, 3, 2, NSA_KV_HEADS, NSA_HEAD_DIM)
    kv_cmp, kv_sel, kv_win = akv[:, :, 0], akv[:, :, 1], akv[:, :, 2]
    win_all = jnp.concatenate([win_buf.astype(x.dtype), kv_win], axis=1)
    y_a = nsa_attention(aq.reshape(B, T, NSA_HEADS, NSA_HEAD_DIM), ag.reshape(B, T, NSA_HEADS, 3),
                        jnp.concatenate([past_cmp.astype(x.dtype), kv_cmp], axis=1),
                        jnp.concatenate([past_sel.astype(x.dtype), kv_sel], axis=1),
                        win_all, pos0, pos0 - win_buf.shape[1], cmp_pos, cmp_w1, cmp_w2) @ w_oa
    pos = pos0 + jnp.arange(T)
    rq = rotary(rq.reshape(B, T, RET_HEADS, RET_DK), pos)
    rk = rotary(rk.reshape(B, T, RET_HEADS, RET_DK), pos) * (RET_DK ** -0.5)
    ro, ret_new = retention(rq, rk, rv.reshape(B, T, RET_HEADS, RET_DV), ret_state)
    ro = group_norm(ro, ret_gn_w.reshape(RET_HEADS, RET_DV)).reshape(B, T, B_V).astype(x.dtype)
    y_b = (jax.nn.silu(rg) * ro) @ w_ob
    x = x + g1 * ((jax.nn.sigmoid(ga) * y_a + jax.nn.sigmoid(gb) * y_b) @ w_o)
    h2 = rmsnorm(x, norm2_w) * (1 + sc2) + sh2
    f, conv_new = conv_ffn(h2, conv_prev, ffn_w_in, ffn_conv_w, ffn_conv_b, ffn_w_out)
    x = x + g2 * f
    return x, (kv_cmp, kv_sel, keep_last(win_all, win_keep), ret_new, conv_new)


def setup_inputs(seed: int = 0) -> dict:
    key = jax.random.key(seed)
    ks = jax.random.split(key, 32)
    f32 = jnp.float32
    n_pages = PAST_LEN // PAGE_SIZE
    used = DEC_BATCH * n_pages
    n_phys = used + max(1, used // 4)
    win_keep = min(WINDOW, PAST_LEN)
    kvs = (2, NSA_KV_HEADS, NSA_HEAD_DIM)

    def nrm(k, shape, s):
        return jax.random.normal(k, shape, f32) * s

    page_table = jax.random.permutation(ks[9], n_phys)[:used].reshape(DEC_BATCH, n_pages).astype(jnp.int32)
    return {
        'x_prompt': nrm(ks[0], (BATCH, SEQ, D_MODEL), 1.0),
        'x_sample': nrm(ks[1], (DEC_BATCH, DEC_SEQ, D_MODEL), 1.0),
        'c_prompt': nrm(ks[2], (BATCH, D_MODEL), 1.0),
        'c_sample': nrm(ks[3], (DEC_BATCH, D_MODEL), 1.0),
        'cache_cmp_kv': nrm(ks[4], (DEPTH, n_phys, PAGE_SIZE) + kvs, 1.0),
        'cache_sel_kv': nrm(ks[5], (DEPTH, n_phys, PAGE_SIZE) + kvs, 1.0),
        'state_win_kv': nrm(ks[6], (DEPTH, DEC_BATCH, win_keep) + kvs, 1.0),
        'state_ret': nrm(ks[7], (DEPTH, DEC_BATCH, RET_HEADS, RET_DK, RET_DV), 0.5),
        'state_conv': nrm(ks[8], (DEPTH, DEC_BATCH, CONV_W - 1, D_FF), 1.0),
        'page_table': page_table,
        'norm1_w': 1.0 + nrm(ks[10], (DEPTH, D_MODEL), 0.02),
        'ada_w': nrm(ks[11], (DEPTH, D_MODEL, 6 * D_MODEL), D_MODEL ** -0.5),
        'ada_b': nrm(ks[12], (DEPTH, 6 * D_MODEL), 0.01),
        'w_in': nrm(ks[13], (DEPTH, D_MODEL, N_IN), D_MODEL ** -0.5),
        'cmp_pos': nrm(ks[14], (DEPTH, 2, CMP_BLOCK, NSA_HEAD_DIM), 0.1),
        'cmp_w1': nrm(ks[15], (DEPTH, 2, CMP_BLOCK * NSA_HEAD_DIM, CMP_HIDDEN), (CMP_BLOCK * NSA_HEAD_DIM) ** -0.5),
        'cmp_w2': nrm(ks[16], (DEPTH, 2, CMP_HIDDEN, NSA_HEAD_DIM), CMP_HIDDEN ** -0.5),
        'w_oa': nrm(ks[17], (DEPTH, A_Q, D_MODEL), A_Q ** -0.5),
        'ret_gn_w': 1.0 + nrm(ks[18], (DEPTH, B_V), 0.02),
        'w_ob': nrm(ks[19], (DEPTH, B_V, D_MODEL), B_V ** -0.5),
        'w_o': nrm(ks[20], (DEPTH, D_MODEL, D_MODEL), D_MODEL ** -0.5),
        'norm2_w': 1.0 + nrm(ks[21], (DEPTH, D_MODEL), 0.02),
        'ffn_w_in': nrm(ks[22], (DEPTH, D_MODEL, 2 * D_FF), D_MODEL ** -0.5),
        'ffn_conv_w': nrm(ks[23], (DEPTH, CONV_W, D_FF), CONV_W ** -0.5),
        'ffn_conv_b': nrm(ks[24], (DEPTH, D_FF), 0.01),
        'ffn_w_out': nrm(ks[25], (DEPTH, D_FF, D_MODEL), D_FF ** -0.5),
        'normf_w': 1.0 + nrm(ks[26], (D_MODEL,), 0.02),
    }


def reference(x_prompt, x_sample, c_prompt, c_sample, cache_cmp_kv, cache_sel_kv, state_win_kv,
              state_ret, state_conv, page_table, norm1_w, ada_w, ada_b, w_in, cmp_pos, cmp_w1,
              cmp_w2, w_oa, ret_gn_w, w_ob, w_o, norm2_w, ffn_w_in, ffn_conv_w, ffn_conv_b,
              ffn_w_out, normf_w):
    B = x_prompt.shape[0]
    win_keep = state_win_kv.shape[2]
    past_len = page_table.shape[1] * cache_cmp_kv.shape[2]
    empty = jnp.zeros((B, 0, 2, NSA_KV_HEADS, NSA_HEAD_DIM), x_prompt.dtype)
    ret0 = jnp.zeros((B, RET_HEADS, RET_DK, RET_DV), jnp.float32)
    conv0 = jnp.zeros((B, CONV_W - 1, D_FF), x_prompt.dtype)
    xp, xs = x_prompt, x_sample
    outs_p, outs_s = [], []
    for l in range(DEPTH):
        w = (norm1_w[l], ada_w[l], ada_b[l], w_in[l], cmp_pos[l], cmp_w1[l], cmp_w2[l], w_oa[l],
             ret_gn_w[l], w_ob[l], w_o[l], norm2_w[l], ffn_w_in[l], ffn_conv_w[l], ffn_conv_b[l],
             ffn_w_out[l])
        xp, sp = decoder_layer(xp, c_prompt, 0, empty, empty, empty, ret0, conv0, win_keep, *w)
        xs, ss = decoder_layer(xs, c_sample, past_len,
                               gather_pages(cache_cmp_kv[l], page_table),
                               gather_pages(cache_sel_kv[l], page_table),
                               state_win_kv[l], state_ret[l], state_conv[l], win_keep, *w)
        outs_p.append(sp)
        outs_s.append(ss)
    y_prompt = rmsnorm(xp, normf_w)
    y_sample = rmsnorm(xs, normf_w)

    def stk(outs, i, dt):
        return jnp.stack([o[i] for o in outs]).astype(dt)

    return (y_prompt, y_sample,
            stk(outs_p, 0, cache_cmp_kv.dtype), stk(outs_s, 0, cache_cmp_kv.dtype),
            stk(outs_p, 1, cache_sel_kv.dtype), stk(outs_s, 1, cache_sel_kv.dtype),
            stk(outs_p, 2, state_win_kv.dtype), stk(outs_s, 2, state_win_kv.dtype),
            stk(outs_p, 3, state_ret.dtype), stk(outs_s, 3, state_ret.dtype),
            stk(outs_p, 4, state_conv.dtype), stk(outs_s, 4, state_conv.dtype))
```

```cpp
#ifndef HOST_SIM
#include <hip/hip_runtime.h>
#define HD __host__ __device__ __forceinline__
#else
#define HD inline
#endif
#include <cstdio>
#include <cstdint>
#include <cmath>

#ifndef CFG_BATCH
#define CFG_BATCH 8
#endif
#ifndef CFG_DEC_BATCH
#define CFG_DEC_BATCH 32
#endif
constexpr int DM = 1024, NB = CFG_BATCH, T = 2048, DEPTH = 2, DB = CFG_DEC_BATCH, DS = 4, PAST = 8192, PAGE = 128;
constexpr int NPAGES = PAST / PAGE, USED = DB * NPAGES, NPHYS = USED + (USED / 4 > 1 ? USED / 4 : 1);
constexpr int NSELP = T / 64, NSELS = (PAST + DS + 63) / 64, NCMPP = T / 16 - 1, NCMPS = (PAST + DS) / 16 - 1;
constexpr int WIN = 512, RH = 4, RDK = 128, RDV = 256, RC = 128, NCH = T / RC, DFF = 2816;
constexpr int BT = NB * T, NS = DB * DS, MREAL = BT + NS, MP = ((MREAL + 255) / 256) * 256;
constexpr int N_IN = 6424, NINP = 6656, NFI = 2 * DFF;
constexpr int NMODROW = NB + DB;
constexpr float C2 = 0.125f * 1.4426950408889634f;
constexpr float NEGF = -1e30f;
constexpr int CMPROWS = NB * 128 + DB * 512;
constexpr int PCW = 512, IMPW = 160;

constexpr long O_YP = 0, O_YS = O_YP + (long)BT * DM, O_CMPP = O_YS + (long)NS * DM, O_CMPS = O_CMPP + 2L * BT * 256,
               O_SELP = O_CMPS + 2L * NS * 256, O_SELS = O_SELP + 2L * BT * 256, O_WINP = O_SELS + 2L * NS * 256,
               O_WINS = O_WINP + 2L * NB * 512 * 256, O_RETP = O_WINS + 2L * DB * 512 * 256, O_RETS = O_RETP + 2L * NB * RH * RDK * RDV,
               O_CONVP = O_RETS + 2L * DB * RH * RDK * RDV, O_CONVS = O_CONVP + 2L * NB * 2 * DFF, O_END = O_CONVS + 2L * DB * 2 * DFF;

typedef unsigned short bf16;
typedef float f32x4 __attribute__((ext_vector_type(4)));
typedef unsigned u32x4 __attribute__((ext_vector_type(4)));

constexpr size_t al256(size_t x) { return (x + 255) & ~(size_t)255; }
constexpr size_t WS_CTL = 0, CTL_ZERO_BYTES = 1u << 20;
constexpr size_t WS_WTIN = CTL_ZERO_BYTES;
constexpr size_t WS_WTOA = WS_WTIN + al256(2UL * NINP * DM * 2);
constexpr size_t WS_WTOB = WS_WTOA + al256(2UL * DM * 512 * 2);
constexpr size_t WS_WTO = WS_WTOB + al256(2UL * DM * DM * 2);
constexpr size_t WS_WTFI = WS_WTO + al256(2UL * DM * DM * 2);
constexpr size_t WS_WTFO = WS_WTFI + al256(2UL * NFI * DM * 2);
constexpr size_t WS_MOD = WS_WTFO + al256(2UL * DM * DFF * 2);
constexpr size_t WS_CB = WS_MOD + al256(2UL * NMODROW * 6144 * 4);
constexpr int NROTPOS = T + DS;
constexpr size_t WS_ROT = WS_CB + al256(2 * 2 * 64 * 4);
constexpr size_t WS_X = WS_ROT + al256((size_t)NROTPOS * 64 * 2 * 4);
constexpr size_t WS_XN = WS_X + al256((size_t)MP * DM * 4);
constexpr size_t WS_QB = WS_XN + al256((size_t)MP * DM * 2);
constexpr size_t WS_KVS = WS_QB + al256((size_t)MP * 512 * 2);
constexpr size_t WS_KVW = WS_KVS + al256((size_t)MP * 256 * 2);
constexpr size_t WS_RQ = WS_KVW + al256((size_t)MP * 256 * 2);
constexpr size_t WS_RK = WS_RQ + al256((size_t)MP * 512 * 2);
constexpr size_t WS_RV = WS_RK + al256((size_t)MP * 512 * 2);
constexpr size_t WS_SRG = WS_RV + al256((size_t)MP * DM * 2);
constexpr size_t WS_SGA = WS_SRG + al256((size_t)MP * DM * 2);
constexpr size_t WS_SGB = WS_SGA + al256((size_t)MP * DM * 2);
constexpr size_t WS_AG = WS_SGB + al256((size_t)MP * DM * 2);
constexpr size_t WS_HID = WS_AG + al256((size_t)MP * 32 * 4);
constexpr size_t WS_KC = WS_HID + al256((size_t)CMPROWS * 256 * 4);
constexpr size_t WS_PC = WS_KC + al256((size_t)CMPROWS * 256 * 2);
constexpr size_t WS_IMP = WS_PC + al256((size_t)MP * 8 * PCW * 4);
constexpr size_t WS_SELB = WS_IMP + al256((size_t)MP * 2 * IMPW * 4);
constexpr size_t WS_OC = WS_SELB + al256((size_t)MP * 2 * IMPW);
constexpr size_t WS_OA = WS_OC + al256((size_t)MP * 512 * 4);
constexpr size_t WS_RETU = WS_OA + al256((size_t)MP * 512 * 2);
constexpr size_t WS_RETS = WS_RETU + al256((size_t)NB * RH * NCH * RDK * RDV * 2);
constexpr size_t WS_INNER = WS_RETS + al256((size_t)NB * RH * NCH * RDK * RDV * 2);
constexpr size_t WS_ORAW = WS_INNER + al256((size_t)NB * RH * NCH * RC * RC * 4);
constexpr size_t WS_RO = WS_ORAW + al256((size_t)MP * DM * 4);
constexpr size_t WS_MIXT = WS_RO + al256((size_t)MP * DM * 2);
constexpr size_t WS_MIX = WS_MIXT + al256((size_t)MP * DM * 4);
constexpr size_t WS_FA = WS_MIX + al256((size_t)MP * DM * 2);
constexpr size_t WS_FB = WS_FA + al256((size_t)MP * DFF * 2);
constexpr size_t WS_G = WS_FB + al256((size_t)MP * DFF * 2);
constexpr size_t WS_W1T = WS_G + al256((size_t)MP * DFF * 2);
constexpr size_t WS_PCMP = WS_W1T + al256(2UL * 2 * 128 * 1024 * 2);
constexpr size_t WS_SHP = WS_PCMP + al256((size_t)CMPROWS * 512 * 4);
constexpr size_t WS_SSP = WS_SHP + al256(3UL * 64 * NINP * 4);
constexpr size_t WS_END = WS_SSP + al256((size_t)MP * 32 * 4);

struct Params {
    const float* in[27];
    float* out;
    unsigned char* ws;
};
enum { I_XP = 0, I_XS, I_CP, I_CS, I_CCMP, I_CSEL, I_SWIN, I_SRET, I_SCONV, I_PT, I_N1W, I_ADAW, I_ADAB, I_WIN, I_CPOS, I_CW1, I_CW2, I_WOA, I_GNW, I_WOB,
       I_WO, I_N2W, I_FWI, I_FCW, I_FCB, I_FWO, I_NFW };

HD unsigned f2bf(float f) { unsigned u = __builtin_bit_cast(unsigned, f); return (u + 0x7fffu + ((u >> 16) & 1u)) >> 16; }
HD float bf2f(bf16 b) { return __builtin_bit_cast(float, (unsigned)b << 16); }
#if defined(HOST_SIM)
HD unsigned pk2(float lo, float hi) { return f2bf(lo) | (f2bf(hi) << 16); }
#else
typedef float pk_f32x2 __attribute__((ext_vector_type(2))); typedef __bf16 pk_bf16x2 __attribute__((ext_vector_type(2)));
__host__ __device__ __forceinline__ unsigned pk2(float lo, float hi) {
#if defined(__HIP_DEVICE_COMPILE__)
    pk_f32x2 v = {lo, hi}; pk_bf16x2 b = __builtin_convertvector(v, pk_bf16x2); return __builtin_bit_cast(unsigned, b);
#else
    return f2bf(lo) | (f2bf(hi) << 16);
#endif
}
#endif
#if defined(HOST_SIM)
HD float sigmoidf_(float x) { return 1.f / (1.f + expf(-x)); }
HD float siluf_(float x) { return x / (1.f + expf(-x)); }
HD float geluf_(float x) { return 0.5f * x * (1.f + tanhf(0.7978845608028654f * (x + 0.044715f * x * x * x))); }
#else
__device__ __forceinline__ float sigmoidf_(float x) { return __builtin_amdgcn_rcpf(1.f + __builtin_amdgcn_exp2f(-1.4426950408889634f * x)); }
__device__ __forceinline__ float siluf_(float x) { return x * sigmoidf_(x); }
__device__ __forceinline__ float geluf_(float x) { return x * __builtin_amdgcn_rcpf(1.f + __builtin_amdgcn_exp2f(-2.302208198f * (x + 0.044715f * x * x * x))); }
#endif
HD float retlg(int h) { return logf(1.f - exp2f(-5.f - (float)h)); }
template <class Tp> HD Tp* wsp(const Params& p, size_t off) { return (Tp*)(p.ws + off); }
struct RowInfo { int kind, b, t, modrow, pos; };
HD RowInfo rowinfo(int m) { RowInfo r; if (m < BT) { r.kind = 0; r.b = m / T; r.t = m % T; r.modrow = r.b; r.pos = r.t; }
    else if (m < MREAL) { r.kind = 1; r.b = (m - BT) / DS; r.t = (m - BT) % DS; r.modrow = NB + r.b; r.pos = PAST + r.t; }
    else { r.kind = 2; r.b = 0; r.t = 0; r.modrow = 0; r.pos = 0; } return r; }

HD int win_srccol(int n) {
    if (n < 1280) return n;
    if (n < 2304) { const int q = n - 1280, seg = q / 512, r = q % 512, head = r / 128, pp = r % 128, j = pp % 8, i0 = 4 * (pp / 8);
        const int d = j < 4 ? i0 + j : 64 + i0 + (j - 4); return 1304 + seg * 512 + head * 128 + d; }
    if (n < 6400) return n + 24;
    if (n < 6424) return 1280 + (n - 6400);
    return -1;
}
HD void st_wt_in(const Params& p, long i) { const int l = (int)(i / ((long)NINP * DM)); const long r = i % ((long)NINP * DM); const int n = (int)(r / DM), k = (int)(r % DM);
    const int sc = win_srccol(n); wsp<bf16>(p, WS_WTIN)[i] = sc < 0 ? (bf16)0 : (bf16)f2bf(p.in[I_WIN][((long)l * DM + k) * N_IN + sc]); }
HD void st_wt_fi(const Params& p, long i) { const int l = (int)(i / ((long)NFI * DM)); const long r = i % ((long)NFI * DM); const int n = (int)(r / DM), k = (int)(r % DM);
    const int pn = n / 256, bj = (n % 256) / 128, q = n % 128; const int sc = bj * DFF + pn * 128 + q;
    wsp<bf16>(p, WS_WTFI)[i] = (bf16)f2bf(p.in[I_FWI][((long)l * DM + k) * NFI + sc]); }
HD void st_wt_plain(const float* W, bf16* WT, int K, int N, long i) {
    const int l = (int)(i / ((long)N * K)); const long r = i % ((long)N * K); const int n = (int)(r / K), k = (int)(r % K);
    WT[i] = (bf16)f2bf(W[((long)l * K + k) * N + n]); }
HD void st_ada(const Params& p, long i) { const int l = (int)(i / ((long)NMODROW * 6144)); const long r = i % ((long)NMODROW * 6144); const int row = (int)(r / 6144), j = (int)(r % 6144);
    const float* c = row < NB ? p.in[I_CP] + (long)row * DM : p.in[I_CS] + (long)(row - NB) * DM;
    const float* w = p.in[I_ADAW] + (long)l * DM * 6144 + j; float acc = p.in[I_ADAB][l * 6144 + j];
    for (int k = 0; k < DM; ++k) acc += siluf_(c[k]) * w[(long)k * 6144];
    wsp<float>(p, WS_MOD)[i] = acc; }
HD void st_cb(const Params& p, long i) { const int l = (int)(i / 128), e = (int)(i / 64) % 2, h = (int)(i % 64);
    const float* pos = p.in[I_CPOS] + ((long)l * 2 + e) * 2048; const float* w1 = p.in[I_CW1] + ((long)l * 2 + e) * 2048 * 64 + h; float acc = 0.f;
    for (int k = 0; k < 2048; ++k) acc += pos[k] * w1[(long)k * 64];
    wsp<float>(p, WS_CB)[i] = acc; }
HD void st_rot(const Params& p, long i) { const int pi = (int)(i / 64), k = (int)(i % 64); const double pos = pi < T ? (double)pi : (double)(PAST + pi - T);
    const double inv = exp(-9.210340371976184 * (double)k * (1.0 / 64.0)); const double ang = pos * inv; const double kk = rint(ang * 0.15915494309189535); const float r = (float)(ang - kk * 6.283185307179586);
    float* o = wsp<float>(p, WS_ROT) + i * 2; o[0] = cosf(r); o[1] = sinf(r); }
HD void st_copywin(const Params& p, long i) {
    const long per = 508L * 256; const int lb = (int)(i / per); const long r = i % per;
    p.out[O_WINS + (long)lb * 512 * 256 + r] = p.in[I_SWIN][(long)lb * 512 * 256 + 4 * 256 + r]; }
HD void st_norm(const Params& p, int l, int which, long m) {
    const RowInfo ri = rowinfo((int)m); bf16* xn = wsp<bf16>(p, WS_XN) + m * DM; float* X = wsp<float>(p, WS_X) + m * DM;
    if (ri.kind == 2) { if (which != 2) for (int k = 0; k < DM; ++k) xn[k] = 0; return; }
    const float* src = X;
    if (which == 0 && l == 0) src = ri.kind == 0 ? p.in[I_XP] + m * DM : p.in[I_XS] + (m - BT) * DM;
    float ss = 0.f; for (int k = 0; k < DM; ++k) { const float v = src[k]; ss += v * v; }
    const float rs = 1.f / sqrtf(ss * (1.f / DM) + 1e-6f);
    if (which == 2) { float* y = ri.kind == 0 ? p.out + O_YP + m * DM : p.out + O_YS + (m - BT) * DM; const float* w = p.in[I_NFW];
        for (int k = 0; k < DM; ++k) y[k] = src[k] * rs * w[k]; return; }
    const float* w = (which == 0 ? p.in[I_N1W] : p.in[I_N2W]) + l * DM; const float* mod = wsp<float>(p, WS_MOD) + ((long)l * NMODROW + ri.modrow) * 6144 + (which == 0 ? 0 : 3072);
    for (int k = 0; k < DM; ++k) { const float v = src[k]; xn[k] = (bf16)f2bf(v * rs * w[k] * (1.f + mod[1024 + k]) + mod[k]); if (which == 0 && l == 0) X[k] = v; }
}
HD const float* cmp_src_tok(const Params& p, int l, int crow, int tok) {
    if (crow < NB * 128) { const int b = crow / 128; return p.out + O_CMPP + (((long)l * NB + b) * T + tok) * 256; }
    const int b = (crow - NB * 128) / 512; const int pg = ((const int*)p.in[I_PT])[b * NPAGES + tok / PAGE];
    return p.in[I_CCMP] + (((long)l * NPHYS + pg) * PAGE + tok % PAGE) * 256; }
HD bool cmp_row_valid(int crow, int& n) { if (crow < NB * 128) { n = crow % 128; return n < NCMPP; } n = (crow - NB * 128) % 512; return n < NCMPS; }
HD void st_hid(const Params& p, int l, long i) { const int crow = (int)(i / 256), rem = (int)(i % 256), e = rem / 128, g = (rem / 64) % 2, h = rem % 64; int n;
    float* dst = wsp<float>(p, WS_HID) + i; if (!cmp_row_valid(crow, n)) { *dst = 0.f; return; }
    float acc = wsp<float>(p, WS_CB)[(l * 2 + e) * 64 + h]; const float* w1 = p.in[I_CW1] + ((long)l * 2 + e) * 2048 * 64 + h;
    for (int lp = 0; lp < 32; ++lp) { const float* kv = cmp_src_tok(p, l, crow, 16 * n + lp) + e * 128 + g * 64;
        for (int d = 0; d < 64; ++d) acc += kv[d] * w1[(long)(lp * 64 + d) * 64]; }
    *dst = geluf_(acc); }
HD void st_kc(const Params& p, int l, long i) { const int crow = (int)(i / 256), rem = (int)(i % 256), e = rem / 128, g = (rem / 64) % 2, d = rem % 64;
    const float* hid = wsp<float>(p, WS_HID) + (long)crow * 256 + e * 128 + g * 64; const float* w2 = p.in[I_CW2] + ((long)l * 2 + e) * 64 * 64 + d; float acc = 0.f;
    for (int h = 0; h < 64; ++h) acc += hid[h] * w2[h * 64];
    wsp<bf16>(p, WS_KC)[i] = (bf16)f2bf(acc); }
HD void st_cmpattn(const Params& p, int l, long i) { const int m = (int)(i / 8), hq = (int)(i % 8), g = hq / 4; const RowInfo ri = rowinfo(m);
    const int kcb = ri.kind == 0 ? ri.b * 128 : NB * 128 + ri.b * 512, ncmp = ri.kind == 0 ? NCMPP : NCMPS;
    int nv = ri.pos >= 31 ? (ri.pos - 31) / 16 + 1 : 0; if (nv > ncmp) nv = ncmp;
    float q[64]; const bf16* qb = wsp<bf16>(p, WS_QB) + (long)m * 512 + hq * 64;
#pragma unroll
    for (int d = 0; d < 64; ++d) q[d] = bf2f(qb[d]);
    float* pc = wsp<float>(p, WS_PC) + ((long)m * 8 + hq) * PCW; const bf16* kc = wsp<bf16>(p, WS_KC) + (long)kcb * 256 + g * 64;
    float mx = NEGF;
    for (int n = 0; n < nv; ++n) { const bf16* k = kc + (long)n * 256; float s = 0.f;
#pragma unroll
        for (int d = 0; d < 64; ++d) s += q[d] * bf2f(k[d]);
        pc[n] = s; mx = fmaxf(mx, s); }
    float o[64];
#pragma unroll
    for (int d = 0; d < 64; ++d) o[d] = 0.f;
    float lsum = 0.f;
    for (int n = 0; n < nv; ++n) { const float pr = exp2f(pc[n] - mx); pc[n] = pr; lsum += pr; const bf16* v = kc + (long)n * 256 + 128;
#pragma unroll
        for (int d = 0; d < 64; ++d) o[d] += pr * bf2f(v[d]); }
    const float il = nv > 0 ? 1.f / lsum : 0.f;
    for (int n = 0; n < nv; ++n) pc[n] *= il;
    for (int n = nv; n < ncmp + 1; ++n) pc[n] = 0.f;
    float* oc = wsp<float>(p, WS_OC) + (long)m * 512 + hq * 64;
#pragma unroll
    for (int d = 0; d < 64; ++d) oc[d] = o[d] * il; }
HD void st_imp(const Params& p, int l, long i) { const int m = (int)(i / (2 * IMPW)), g = (int)(i / IMPW) % 2, j = (int)(i % IMPW); const RowInfo ri = rowinfo(m);
    const int nsel = ri.kind == 0 ? NSELP : NSELS, ncmp = ri.kind == 0 ? NCMPP : NCMPS; float* dst = wsp<float>(p, WS_IMP) + i;
    if (j >= nsel) { *dst = NEGF; return; }
    float imp = 0.f;
    for (int hq = 0; hq < 4; ++hq) { const float* pc = wsp<float>(p, WS_PC) + ((long)m * 8 + g * 4 + hq) * PCW;
        for (int n = 4 * j - 1; n <= 4 * j + 3; ++n) if (n >= 0 && n < ncmp) imp += pc[n]; }
    const int cur = ri.pos / 64; const bool ok = j * 64 <= ri.pos, forced = (j == 0) || (j == cur) || (j == cur - 1);
    *dst = ok ? imp + (forced ? 1e4f : 0.f) : NEGF; }
HD void st_topk(const Params& p, int l, long i) { const int m = (int)(i / (2 * IMPW)), g = (int)(i / IMPW) % 2, j = (int)(i % IMPW); const RowInfo ri = rowinfo(m);
    const int nsel = ri.kind == 0 ? NSELP : NSELS; unsigned char* dst = wsp<unsigned char>(p, WS_SELB) + i;
    if (j >= nsel) { *dst = 0; return; }
    const float* sc = wsp<float>(p, WS_IMP) + ((long)m * 2 + g) * IMPW; const float s = sc[j]; int rank = 0;
    for (int jj = 0; jj < nsel; ++jj) { const float t = sc[jj]; rank += (t > s || (t == s && jj < j)) ? 1 : 0; }
    *dst = (rank < 16 && s > 0.5f * NEGF) ? 1 : 0; }
HD float rbf(float x) { return bf2f((bf16)f2bf(x)); }
HD void st_selwin(const Params& p, int l, long i) { const int m = (int)(i / 8), hq = (int)(i % 8), g = hq / 4; const RowInfo ri = rowinfo(m);
    float q[64]; const bf16* qb = wsp<bf16>(p, WS_QB) + (long)m * 512 + hq * 64;
#pragma unroll
    for (int d = 0; d < 64; ++d) q[d] = bf2f(qb[d]);
    const float* ag = wsp<float>(p, WS_AG) + (long)m * 32 + hq * 3; float* oc = wsp<float>(p, WS_OC) + (long)m * 512 + hq * 64;
    const unsigned char* selb = wsp<unsigned char>(p, WS_SELB) + ((long)m * 2 + g) * IMPW; const int nsel = ri.kind == 0 ? NSELP : NSELS;
    for (int br = 1; br < 3; ++br) {
        float o[64], mx = NEGF, lsum = 0.f;
#pragma unroll
        for (int d = 0; d < 64; ++d) o[d] = 0.f;
        int tlo = 0; const int thi = ri.pos; if (br == 2) { tlo = ri.pos - (WIN - 1); if (tlo < 0) tlo = 0; }
        for (int tok = tlo; tok <= thi; ++tok) {
            if (br == 1) { const int j = tok / 64; if (j >= nsel || !selb[j]) { tok = j * 64 + 63; continue; } }
            const bf16* sb = nullptr; const float* sf = nullptr;
            if (ri.kind == 0 || tok >= PAST) { const long row = ri.kind == 0 ? (long)ri.b * T + tok : (long)BT + ri.b * DS + (tok - PAST); sb = wsp<bf16>(p, br == 1 ? WS_KVS : WS_KVW) + row * 256 + g * 64; }
            else if (br == 1) { const int pg = ((const int*)p.in[I_PT])[ri.b * NPAGES + tok / PAGE]; sf = p.in[I_CSEL] + (((long)l * NPHYS + pg) * PAGE + tok % PAGE) * 256 + g * 64; }
            else sf = p.in[I_SWIN] + (((long)l * DB + ri.b) * 512 + (tok - (PAST - 512))) * 256 + g * 64;
            float s = 0.f;
            if (sb) {
#pragma unroll
                for (int d = 0; d < 64; ++d) s += q[d] * bf2f(sb[d]); }
            else {
#pragma unroll
                for (int d = 0; d < 64; ++d) s += q[d] * rbf(sf[d]); }
            if (s > mx) { const float f = exp2f(mx - s); lsum *= f;
#pragma unroll
                for (int d = 0; d < 64; ++d) o[d] *= f;
                mx = s; }
            const float pr = exp2f(s - mx); lsum += pr;
            if (sb) {
#pragma unroll
                for (int d = 0; d < 64; ++d) o[d] += pr * bf2f(sb[128 + d]); }
            else {
#pragma unroll
                for (int d = 0; d < 64; ++d) o[d] += pr * rbf(sf[128 + d]); } }
        const float gl = ag[br] / lsum;
        if (br == 1) {
#pragma unroll
            for (int d = 0; d < 64; ++d) oc[d] = ag[0] * oc[d] + gl * o[d]; }
        else { bf16* oa = wsp<bf16>(p, WS_OA) + (long)m * 512 + hq * 64;
#pragma unroll
            for (int d = 0; d < 64; ++d) oa[d] = (bf16)f2bf(oc[d] + gl * o[d]); } } }
HD void st_retU(const Params& p, long i) { const int j = (int)(i % RDV), ii = (int)(i / RDV) % RDK, n = (int)(i / (RDV * RDK)) % NCH, h = (int)(i / ((long)RDV * RDK * NCH)) % RH, b = (int)(i / ((long)RDV * RDK * NCH * RH));
    const float lg = retlg(h); const bf16* rk = wsp<bf16>(p, WS_RK) + ((long)b * T + n * RC) * 512 + h * RDK + ii; const bf16* rv = wsp<bf16>(p, WS_RV) + ((long)b * T + n * RC) * DM + h * RDV + j; float acc = 0.f;
    for (int c = 0; c < RC; ++c) acc += bf2f(rk[(long)c * 512]) * expf((float)(RC - 1 - c) * lg) * bf2f(rv[(long)c * DM]);
    wsp<bf16>(p, WS_RETU)[i] = (bf16)f2bf(acc); }
HD void st_retS(const Params& p, int l, long i) { const int j = (int)(i % RDV), ii = (int)(i / RDV) % RDK, h = (int)(i / (RDV * RDK)) % RH, b = (int)(i / (RDV * RDK * RH));
    const float sdec = expf((float)RC * retlg(h)); float S = 0.f;
    for (int n = 0; n < NCH; ++n) { const long idx = ((((long)b * RH + h) * NCH + n) * RDK + ii) * RDV + j; wsp<bf16>(p, WS_RETS)[idx] = (bf16)f2bf(S); S = S * sdec + bf2f(wsp<bf16>(p, WS_RETU)[idx]); }
    p.out[O_RETP + ((((long)l * NB + b) * RH + h) * RDK + ii) * RDV + j] = S; }
HD void st_inner(const Params& p, long i) { const int e = (int)(i % RC), c = (int)(i / RC) % RC, n = (int)(i / (RC * RC)) % NCH, h = (int)(i / (RC * RC * NCH)) % RH, b = (int)(i / (RC * RC * NCH * RH));
    float* dst = wsp<float>(p, WS_INNER) + i; if (e > c) { *dst = 0.f; return; }
    const bf16* q = wsp<bf16>(p, WS_RQ) + ((long)b * T + n * RC + c) * 512 + h * RDK; const bf16* k = wsp<bf16>(p, WS_RK) + ((long)b * T + n * RC + e) * 512 + h * RDK; float acc = 0.f;
    for (int d = 0; d < RDK; ++d) acc += bf2f(q[d]) * bf2f(k[d]);
    *dst = acc * expf((float)(c - e) * retlg(h)); }
HD void st_retO(const Params& p, long i) { const int j = (int)(i % RDV), h = (int)(i / RDV) % RH; const long m = i / (RDV * RH); const int b = (int)(m / T), t = (int)(m % T), n = t / RC, c = t % RC;
    const float* inner = wsp<float>(p, WS_INNER) + ((((long)b * RH + h) * NCH + n) * RC + c) * RC; const bf16* rv = wsp<bf16>(p, WS_RV) + ((long)b * T + n * RC) * DM + h * RDV + j; float acc = 0.f;
    for (int e = 0; e <= c; ++e) acc += inner[e] * bf2f(rv[(long)e * DM]);
    const bf16* q = wsp<bf16>(p, WS_RQ) + m * 512 + h * RDK; const bf16* S = wsp<bf16>(p, WS_RETS) + ((((long)b * RH + h) * NCH + n) * RDK) * RDV + j; float acc2 = 0.f;
    for (int d = 0; d < RDK; ++d) acc2 += bf2f(q[d]) * bf2f(S[(long)d * RDV]);
    wsp<float>(p, WS_ORAW)[m * DM + h * RDV + j] = acc + acc2 * expf((float)(c + 1) * retlg(h)); }
HD void st_retOs(const Params& p, int l, long i) { const int j = (int)(i % RDV), h = (int)(i / RDV) % RH; const int sr = (int)(i / (RDV * RH)), b = sr / DS, t = sr % DS; const long m = BT + sr; const float lg = retlg(h);
    const bf16* q = wsp<bf16>(p, WS_RQ) + m * 512 + h * RDK; float acc = 0.f;
    for (int e = 0; e <= t; ++e) { const long me = BT + b * DS + e; const bf16* k = wsp<bf16>(p, WS_RK) + me * 512 + h * RDK; float s = 0.f;
        for (int d = 0; d < RDK; ++d) s += bf2f(q[d]) * bf2f(k[d]);
        acc += s * expf((float)(t - e) * lg) * bf2f(wsp<bf16>(p, WS_RV)[me * DM + h * RDV + j]); }
    const float* S0 = p.in[I_SRET] + ((((long)l * DB + b) * RH + h) * RDK) * RDV + j; float acc2 = 0.f;
    for (int d = 0; d < RDK; ++d) acc2 += bf2f(q[d]) * S0[(long)d * RDV];
    wsp<float>(p, WS_ORAW)[m * DM + h * RDV + j] = acc + acc2 * expf((float)(t + 1) * lg); }
HD void st_retSs(const Params& p, int l, long i) { const int j = (int)(i % RDV), ii = (int)(i / RDV) % RDK, h = (int)(i / (RDV * RDK)) % RH, b = (int)(i / (RDV * RDK * RH)); const float lg = retlg(h);
    const long idx = ((((long)l * DB + b) * RH + h) * RDK + ii) * RDV + j; float S = p.in[I_SRET][idx] * expf((float)DS * lg);
    for (int c = 0; c < DS; ++c) { const long mc = BT + b * DS + c; S += bf2f(wsp<bf16>(p, WS_RK)[mc * 512 + h * RDK + ii]) * expf((float)(DS - 1 - c) * lg) * bf2f(wsp<bf16>(p, WS_RV)[mc * DM + h * RDV + j]); }
    p.out[O_RETS + idx] = S; }
HD void st_gn(const Params& p, int l, long i) { const long m = i / RH; const int h = (int)(i % RH); const float* o = wsp<float>(p, WS_ORAW) + m * DM + h * RDV; float mu = 0.f;
    for (int j = 0; j < RDV; ++j) mu += o[j];
    mu *= (1.f / RDV); float var = 0.f;
    for (int j = 0; j < RDV; ++j) { const float d = o[j] - mu; var += d * d; }
    const float rs = 1.f / sqrtf(var * (1.f / RDV) + 1e-5f); const float* w = p.in[I_GNW] + l * DM + h * RDV; const bf16* srg = wsp<bf16>(p, WS_SRG) + m * DM + h * RDV; bf16* ro = wsp<bf16>(p, WS_RO) + m * DM + h * RDV;
    for (int j = 0; j < RDV; ++j) ro[j] = (bf16)f2bf(bf2f(srg[j]) * (o[j] - mu) * rs * w[j]); }
HD void st_conv(const Params& p, int l, long i) { const long m = i / DFF; const int col = (int)(i % DFF); const RowInfo ri = rowinfo((int)m);
    const bf16* fa = wsp<bf16>(p, WS_FA); const float* cw = p.in[I_FCW] + (long)l * 3 * DFF + col;
    const float* prev = ri.kind == 1 ? p.in[I_SCONV] + (((long)l * DB + ri.b) * 2) * DFF + col : nullptr;
    const float a0 = bf2f(fa[m * DFF + col]);
    const float a1 = ri.t >= 1 ? bf2f(fa[(m - 1) * DFF + col]) : (prev ? prev[DFF] : 0.f);
    const float a2 = ri.t >= 2 ? bf2f(fa[(m - 2) * DFF + col]) : (prev ? prev[ri.t * DFF] : 0.f);
    const float u = p.in[I_FCB][l * DFF + col] + a2 * cw[0] + a1 * cw[DFF] + a0 * cw[2 * DFF];
    wsp<bf16>(p, WS_G)[m * DFF + col] = (bf16)f2bf(geluf_(u) * bf2f(wsp<bf16>(p, WS_FB)[m * DFF + col])); }
HD void st_zero_pad(const Params& p, long i) { const long r = i / 4352, c = i % 4352; const long m = MREAL + r;
    if (c < 512) wsp<bf16>(p, WS_OA)[m * 512 + c] = 0; else if (c < 1536) wsp<bf16>(p, WS_RO)[m * DM + c - 512] = 0; else wsp<bf16>(p, WS_G)[m * DFF + c - 1536] = 0; }


HD const float* fuse_nw(const Params& p, int l, int kind) { return kind == 0 ? p.in[I_N2W] + l * DM : p.in[I_N1W] + (l + 1) * DM; }
HD const float* fuse_sc(const Params& p, int l, int kind, int modrow) { return kind == 0 ? wsp<float>(p, WS_MOD) + ((long)l * NMODROW + modrow) * 6144 + 4096 : wsp<float>(p, WS_MOD) + ((long)(l + 1) * NMODROW + modrow) * 6144 + 1024; }
#ifdef HOST_SIM
constexpr int SSP_PROMPT = 16, SSP_SAMPLE = 16;
#else
constexpr int SSP_PROMPT = 16, SSP_SAMPLE = 32;
#endif
HD float fuse_rs_fin(f32x4 a) { return 1.f / sqrtf(((a[0] + a[1]) + (a[2] + a[3])) * (1.f / DM) + 1e-6f); }
HD void fuse_rs8(const Params& p, int pm, int wr, int fr, float (&rsv)[2][4]) {
    const float* sp = wsp<float>(p, WS_SSP) + (long)(pm * 256 + wr * 64 + fr) * 32;
#ifndef HOST_SIM
    if (pm < BT / 256) {
#endif
        f32x4 a[2][4];
#pragma unroll
        for (int ai = 0; ai < 2; ++ai)
#pragma unroll
            for (int m = 0; m < 4; ++m) a[ai][m] = *(const f32x4*)(sp + (long)(ai * 128 + m * 16) * 32);
#pragma unroll
        for (int ai = 0; ai < 2; ++ai)
#pragma unroll
            for (int m = 0; m < 4; ++m) rsv[ai][m] = fuse_rs_fin(a[ai][m]);
#ifndef HOST_SIM
    } else {
#pragma unroll
        for (int ai = 0; ai < 2; ++ai)
#pragma unroll
            for (int m = 0; m < 4; ++m) { const float* s2 = sp + (long)(ai * 128 + m * 16) * 32; f32x4 a = *(const f32x4*)s2;
#pragma unroll
                for (int k = 1; k < 8; ++k) a += *(const f32x4*)(s2 + 4 * k);
                rsv[ai][m] = fuse_rs_fin(a); } }
#endif
}
HD void st_shp(const Params& p, long i) { const int col = (int)(i % NINP), r = (int)(i / NINP) % NMODROW, which = (int)(i / ((long)NINP * NMODROW));
    const int ncol = which == 2 ? NINP : NFI; if (col >= ncol) return;
    const float* sh = which == 2 ? wsp<float>(p, WS_MOD) + ((long)1 * NMODROW + r) * 6144 : wsp<float>(p, WS_MOD) + ((long)which * NMODROW + r) * 6144 + 3072;
    const bf16* w = which == 2 ? wsp<bf16>(p, WS_WTIN) + (size_t)1 * NINP * DM + (size_t)col * DM : wsp<bf16>(p, WS_WTFI) + (size_t)which * NFI * DM + (size_t)col * DM; float acc = 0.f;
    for (int k = 0; k < DM; ++k) acc += bf2f((bf16)f2bf(sh[k])) * bf2f(w[k]);
    wsp<float>(p, WS_SHP)[((long)which * 64 + r) * NINP + col] = acc; }

struct Unit { int pm, pn; };
HD void st8bf(bf16* dst, const float* v) { u32x4 w; w.x = pk2(v[0], v[1]); w.y = pk2(v[2], v[3]); w.z = pk2(v[4], v[5]); w.w = pk2(v[6], v[7]); *(u32x4*)dst = w; }
#define EPI_BEGIN \
    _Pragma("unroll") for (int ai = 0; ai < 2; ++ai) _Pragma("unroll") for (int m = 0; m < 4; ++m) _Pragma("unroll") for (int bj = 0; bj < 2; ++bj) { \
        const int row = u.pm * 256 + ai * 128 + wr * 64 + m * 16 + fr, col = u.pn * 256 + bj * 128 + wc * 32 + fq * 8; \
        float v[8]; _Pragma("unroll") for (int q_ = 0; q_ < 4; ++q_) { v[q_] = acc[ai][bj][m][0][q_]; v[4 + q_] = acc[ai][bj][m][1][q_]; }
#ifndef HOST_SIM
#define EPI_END asm volatile("" ::: "memory"); }
#else
#define EPI_END }
#endif

struct EpiInProj {
    static constexpr bool PERM = true, AFTER_DRAIN = false;
    Params p; int l, fused;
    HD void operator()(const f32x4 (&acc)[2][2][4][2], const Unit& u, int wr, int wc, int fr, int fq) const {
        const int pn = u.pn;
        float rsv[2][4]; f32x4 ha0 = {0.f, 0.f, 0.f, 0.f}, ha1 = ha0, hb0 = ha0, hb1 = ha0; const bool uni = u.pm < BT / 256;
        if (fused) { fuse_rs8(p, u.pm, wr, fr, rsv);
            if (uni) {
                const float* sh = wsp<float>(p, WS_SHP) + ((long)2 * 64 + (u.pm * 256) / T) * NINP + u.pn * 256 + wc * 32 + fq * 8; ha0 = *(const f32x4*)sh; ha1 = *(const f32x4*)(sh + 4); hb0 = *(const f32x4*)(sh + 128); hb1 = *(const f32x4*)(sh + 132); } }
        EPI_BEGIN {
            const RowInfo ri = rowinfo(row);
            if (fused) { const float rs = rsv[ai][m]; f32x4 h0 = bj == 0 ? ha0 : hb0, h1 = bj == 0 ? ha1 : hb1;
                if (!uni) { const float* sh = wsp<float>(p, WS_SHP) + ((long)2 * 64 + ri.modrow) * NINP + col; h0 = *(const f32x4*)sh; h1 = *(const f32x4*)(sh + 4); }
#pragma unroll
                for (int k = 0; k < 4; ++k) { v[k] = v[k] * rs + h0[k]; v[4 + k] = v[4 + k] * rs + h1[k]; } }
            if (pn < 2) { float s[8];
#pragma unroll
                for (int k = 0; k < 8; ++k) s[k] = v[k] * C2;
                st8bf(wsp<bf16>(p, WS_QB) + (long)row * 512 + col, s); }
            else if (pn < 5) { const int c = col - (512 + 256 * (pn - 2));
                float* o = nullptr;
                if (pn == 2) { if (ri.kind == 0) o = p.out + O_CMPP + (((long)l * NB + ri.b) * T + ri.t) * 256 + c; else if (ri.kind == 1) o = p.out + O_CMPS + (((long)l * DB + ri.b) * DS + ri.t) * 256 + c; }
                else if (pn == 3) { if (ri.kind == 0) o = p.out + O_SELP + (((long)l * NB + ri.b) * T + ri.t) * 256 + c; else if (ri.kind == 1) o = p.out + O_SELS + (((long)l * DB + ri.b) * DS + ri.t) * 256 + c;
                    st8bf(wsp<bf16>(p, WS_KVS) + (long)row * 256 + c, v); }
                else { if (ri.kind == 0) { if (ri.t >= T - WIN) o = p.out + O_WINP + (((long)l * NB + ri.b) * WIN + (ri.t - (T - WIN))) * 256 + c; } else if (ri.kind == 1) o = p.out + O_WINS + (((long)l * DB + ri.b) * WIN + (WIN - DS) + ri.t) * 256 + c;
                    st8bf(wsp<bf16>(p, WS_KVW) + (long)row * 256 + c, v); }
                if (o) { *(f32x4*)o = (f32x4){v[0], v[1], v[2], v[3]}; *(f32x4*)(o + 4) = (f32x4){v[4], v[5], v[6], v[7]}; } }
            else if (pn < 9) { const int q = col - 1280, seg = q / 512, r = q % 512, head = r / 128, i0 = 4 * ((r % 128) / 8); const float sc = seg == 0 ? 1.f : 0.08838834764831845f;
                bf16* dst = wsp<bf16>(p, seg == 0 ? WS_RQ : WS_RK) + (long)row * 512 + head * 128; unsigned w1[2], w2[2]; float o1[4], o2[4];
                const float* rot = wsp<float>(p, WS_ROT) + ((long)(ri.kind == 1 ? T + ri.t : ri.t) * 64 + i0) * 2;
                const f32x4 ra = *(const f32x4*)rot, rb = *(const f32x4*)(rot + 4); const float cs4[4] = {ra[0], ra[2], rb[0], rb[2]}, sn4[4] = {ra[1], ra[3], rb[1], rb[3]};
#pragma unroll
                for (int k = 0; k < 4; ++k) { const float cs = cs4[k], sn = sn4[k];
                    o1[k] = (v[k] * cs - v[4 + k] * sn) * sc; o2[k] = (v[k] * sn + v[4 + k] * cs) * sc; }
                w1[0] = pk2(o1[0], o1[1]); w1[1] = pk2(o1[2], o1[3]); w2[0] = pk2(o2[0], o2[1]); w2[1] = pk2(o2[2], o2[3]);
                *(unsigned long long*)(dst + i0) = (unsigned long long)w1[0] | ((unsigned long long)w1[1] << 32); *(unsigned long long*)(dst + 64 + i0) = (unsigned long long)w2[0] | ((unsigned long long)w2[1] << 32); }
            else if (pn < 13) st8bf(wsp<bf16>(p, WS_RV) + (long)row * DM + (col - 2304), v);
            else if (pn < 17) { float s[8];
#pragma unroll
                for (int k = 0; k < 8; ++k) s[k] = siluf_(v[k]);
                st8bf(wsp<bf16>(p, WS_SRG) + (long)row * DM + (col - 3328), s); }
            else if (pn < 25) { float s[8];
#pragma unroll
                for (int k = 0; k < 8; ++k) s[k] = sigmoidf_(v[k]);
                st8bf(wsp<bf16>(p, pn < 21 ? WS_SGA : WS_SGB) + (long)row * DM + (col - (pn < 21 ? 4352 : 5376)), s); }
            else { const int c = col - 6400; if (c < 24) { float* o = wsp<float>(p, WS_AG) + (long)row * 32 + c;
#pragma unroll
                    for (int k = 0; k < 8; ++k) o[k] = sigmoidf_(v[k]); } }
        } EPI_END
    }
};
HD void up8f(const bf16* src, float* f) { const u32x4 w = *(const u32x4*)src;
#pragma unroll
    for (int k = 0; k < 4; ++k) { f[2 * k] = __builtin_bit_cast(float, w[k] << 16); f[2 * k + 1] = __builtin_bit_cast(float, w[k] & 0xffff0000u); } }
struct EpiMixA {
    static constexpr bool PERM = true, AFTER_DRAIN = false;
    Params p;
    HD void operator()(const f32x4 (&acc)[2][2][4][2], const Unit& u, int wr, int wc, int fr, int fq) const {
        EPI_BEGIN { float g[8]; up8f(wsp<bf16>(p, WS_SGA) + (long)row * DM + col, g); float* o = wsp<float>(p, WS_MIXT) + (long)row * DM + col;
            *(f32x4*)o = (f32x4){g[0] * v[0], g[1] * v[1], g[2] * v[2], g[3] * v[3]}; *(f32x4*)(o + 4) = (f32x4){g[4] * v[4], g[5] * v[5], g[6] * v[6], g[7] * v[7]}; } EPI_END
    }
};
struct EpiMixB {
    static constexpr bool PERM = true, AFTER_DRAIN = false;
    Params p;
    HD void operator()(const f32x4 (&acc)[2][2][4][2], const Unit& u, int wr, int wc, int fr, int fq) const {
        EPI_BEGIN { float g[8]; up8f(wsp<bf16>(p, WS_SGB) + (long)row * DM + col, g); const float* t = wsp<float>(p, WS_MIXT) + (long)row * DM + col; const f32x4 t0 = *(const f32x4*)t, t1 = *(const f32x4*)(t + 4); float s[8];
#pragma unroll
            for (int k = 0; k < 4; ++k) { s[k] = t0[k] + g[k] * v[k]; s[4 + k] = t1[k] + g[4 + k] * v[4 + k]; }
            st8bf(wsp<bf16>(p, WS_MIX) + (long)row * DM + col, s); } EPI_END
    }
};
struct EpiResid {
    static constexpr bool PERM = true, AFTER_DRAIN = false;
    Params p; int l, goff, nkind, xin;
    HD void operator()(const f32x4 (&acc)[2][2][4][2], const Unit& u, int wr, int wc, int fr, int fq) const {
        float ssq = 0.f;
#ifndef HOST_SIM
        __attribute__((address_space(3))) float* ex = (__attribute__((address_space(3))) float*)(unsigned)132096;
#endif
        const bool uni = u.pm < BT / 256; f32x4 gg[2][2], ns[2][2];
#pragma unroll
        for (int b2 = 0; b2 < 2; ++b2)
#pragma unroll
            for (int hh = 0; hh < 2; ++hh) { gg[b2][hh] = (f32x4){0.f, 0.f, 0.f, 0.f}; ns[b2][hh] = gg[b2][hh]; }
        if (uni) { const int mr = (u.pm * 256) / T;
#pragma unroll
            for (int b2 = 0; b2 < 2; ++b2) { const int c0 = u.pn * 256 + b2 * 128 + wc * 32 + fq * 8; const float* g = wsp<float>(p, WS_MOD) + ((long)l * NMODROW + mr) * 6144 + goff + c0; gg[b2][0] = *(const f32x4*)g; gg[b2][1] = *(const f32x4*)(g + 4);
                if (nkind >= 0) { const float* nw = fuse_nw(p, l, nkind) + c0; const float* sc = fuse_sc(p, l, nkind, mr) + c0; ns[b2][0] = *(const f32x4*)nw * (*(const f32x4*)sc + 1.f); ns[b2][1] = *(const f32x4*)(nw + 4) * (*(const f32x4*)(sc + 4) + 1.f); } } }
#pragma unroll
        for (int ai = 0; ai < 2; ++ai)
#pragma unroll
            for (int m = 0; m < 4; ++m)
#pragma unroll
                for (int bj = 0; bj < 2; ++bj) {
                    const int row = u.pm * 256 + ai * 128 + wr * 64 + m * 16 + fr, col = u.pn * 256 + bj * 128 + wc * 32 + fq * 8;
                    f32x4 g0 = gg[bj][0], g1 = gg[bj][1], n0 = ns[bj][0], n1 = ns[bj][1];
                    if (!uni) { const RowInfo ri = rowinfo(row); const float* g = wsp<float>(p, WS_MOD) + ((long)l * NMODROW + ri.modrow) * 6144 + goff + col; g0 = *(const f32x4*)g; g1 = *(const f32x4*)(g + 4);
                        if (nkind >= 0) { const float* nw = fuse_nw(p, l, nkind) + col; const float* sc = fuse_sc(p, l, nkind, ri.modrow) + col; n0 = *(const f32x4*)nw * (*(const f32x4*)sc + 1.f); n1 = *(const f32x4*)(nw + 4) * (*(const f32x4*)(sc + 4) + 1.f); } }
                    float* x = wsp<float>(p, WS_X) + (long)row * DM + col;
                    const float* xs = xin ? (row < BT ? p.in[I_XP] + (long)row * DM : p.in[I_XS] + (long)(row < MREAL ? row - BT : 0) * DM) + col : x;
                    const f32x4 y0 = *(const f32x4*)xs + g0 * acc[ai][bj][m][0], y1 = *(const f32x4*)(xs + 4) + g1 * acc[ai][bj][m][1];
                    *(f32x4*)x = y0; *(f32x4*)(x + 4) = y1;
                    if (nkind >= 0) { const f32x4 h0 = y0 * n0, h1 = y1 * n1; float h[8];
#pragma unroll
                        for (int k = 0; k < 4; ++k) { h[k] = h0[k]; h[4 + k] = h1[k]; ssq += y0[k] * y0[k] + y1[k] * y1[k]; }
                        st8bf(wsp<bf16>(p, WS_XN) + (long)row * DM + col, h);
                        if (bj == 1) {
#ifdef HOST_SIM
                            float* sp = wsp<float>(p, WS_SSP) + (long)row * 32 + u.pn;
                            if (wc == 0 && fq == 0) *sp = ssq; else *sp += ssq;
#else
                            ssq += __shfl_xor(ssq, 16); ssq += __shfl_xor(ssq, 32); if (fq == 0) ex[(ai * 128 + wr * 64 + m * 16 + fr) * 4 + wc] = ssq;
#endif
                            ssq = 0.f; } } }
#ifndef HOST_SIM
        if (nkind >= 0) { asm volatile("s_waitcnt lgkmcnt(0)\n\ts_barrier" ::: "memory");
            const int t_ = wr * 256 + wc * 64 + fq * 16 + fr;
            if (t_ < 256) { const f32x4 e4 = *(const __attribute__((address_space(3))) f32x4*)(ex + t_ * 4); wsp<float>(p, WS_SSP)[(long)(u.pm * 256 + t_) * 32 + u.pn] = (e4[0] + e4[1]) + (e4[2] + e4[3]); }
            asm volatile("s_waitcnt lgkmcnt(0)\n\ts_barrier" ::: "memory"); }
#endif
    }
};
#ifndef HOST_SIM
__device__ __forceinline__ float dpp_prev(float prevgrp, float cur, int which  ) {
    const int pg = __builtin_bit_cast(int, prevgrp), cu = __builtin_bit_cast(int, cur);
    if (which == 1) { const int t = __builtin_amdgcn_update_dpp(pg, pg, 0x121, 0xf, 0xf, false); return __builtin_bit_cast(float, __builtin_amdgcn_update_dpp(t, cu, 0x111, 0xf, 0xf, false)); }
    const int t = __builtin_amdgcn_update_dpp(pg, pg, 0x122, 0xf, 0xf, false); return __builtin_bit_cast(float, __builtin_amdgcn_update_dpp(t, cu, 0x112, 0xf, 0xf, false));
}
#endif
struct EpiFfnIn {
    static constexpr bool PERM = true, AFTER_DRAIN = false;
    Params p; int l, fused;
    HD void operator()(const f32x4 (&acc)[2][2][4][2], const Unit& u, int wr, int wc, int fr, int fq) const {
        float rsv[2][4]; f32x4 ha0 = {0.f, 0.f, 0.f, 0.f}, ha1 = ha0, hb0 = ha0, hb1 = ha0; const bool uni = u.pm < BT / 256;
        if (fused) { fuse_rs8(p, u.pm, wr, fr, rsv);
            if (uni) {
                const float* sh = wsp<float>(p, WS_SHP) + ((long)l * 64 + (u.pm * 256) / T) * NINP + u.pn * 256 + wc * 32 + fq * 8; ha0 = *(const f32x4*)sh; ha1 = *(const f32x4*)(sh + 4); hb0 = *(const f32x4*)(sh + 128); hb1 = *(const f32x4*)(sh + 132); } }
#ifndef HOST_SIM
        if (uni && !fused) {
            const int c = u.pn * 128 + wc * 32 + fq * 8; const bool seq0 = (u.pm % (T / 256)) == 0;
            __attribute__((address_space(3))) float* hx = (__attribute__((address_space(3))) float*)(unsigned)(132096 + 4096);
            if (fr >= 14) {
#pragma unroll
                for (int ai = 0; ai < 2; ++ai) { __attribute__((address_space(3))) float* d = hx + ((ai * 2 + wr) * 4 + wc) * 64 + (fr - 14) * 32 + fq * 8;
                    *(__attribute__((address_space(3))) f32x4*)d = acc[ai][0][3][0]; *(__attribute__((address_space(3))) f32x4*)(d + 4) = acc[ai][0][3][1]; } }
            const float* cwp = p.in[I_FCW] + (long)l * 3 * DFF + c; const float* cbp = p.in[I_FCB] + l * DFF + c;
            f32x4 w0[2], w1[2], w2[2], bb[2];
#pragma unroll
            for (int hh = 0; hh < 2; ++hh) { w0[hh] = *(const f32x4*)(cwp + 4 * hh); w1[hh] = *(const f32x4*)(cwp + DFF + 4 * hh); w2[hh] = *(const f32x4*)(cwp + 2 * DFF + 4 * hh); bb[hh] = *(const f32x4*)(cbp + 4 * hh); }
            asm volatile("s_waitcnt lgkmcnt(0)\n\ts_barrier" ::: "memory");
#pragma unroll
            for (int ai = 0; ai < 2; ++ai)
#pragma unroll
                for (int m = 0; m < 4; ++m) {
                    const int row = u.pm * 256 + ai * 128 + wr * 64 + m * 16 + fr;
                    f32x4 pv0, pv1;
                    if (m > 0) { pv0 = acc[ai][0][m - 1][0]; pv1 = acc[ai][0][m - 1][1]; }
                    else if (ai == 0 && wr == 0) { pv0 = (f32x4){0.f, 0.f, 0.f, 0.f}; pv1 = pv0; }
                    else { const int pg = ai * 2 + wr - 1; const __attribute__((address_space(3))) float* d = hx + (pg * 4 + wc) * 64 + ((fr >= 14 ? fr : 14) - 14) * 32 + fq * 8;
                        pv0 = *(const __attribute__((address_space(3))) f32x4*)d; pv1 = *(const __attribute__((address_space(3))) f32x4*)(d + 4); }
                    const bool defer = (ai == 0 && wr == 0 && m == 0 && fr < 2 && !seq0);
                    float g[8]; float av[8]; float bv[8];
#pragma unroll
                    for (int k = 0; k < 8; ++k) { const float cur = acc[ai][0][m][k >> 2][k & 3], pg_ = (k < 4 ? pv0 : pv1)[k & 3];
                        const float p1 = dpp_prev(pg_, cur, 1), p2 = dpp_prev(pg_, cur, 2);
                        const float uu = bb[k >> 2][k & 3] + p2 * w0[k >> 2][k & 3] + p1 * w1[k >> 2][k & 3] + cur * w2[k >> 2][k & 3];
                        av[k] = cur; bv[k] = acc[ai][1][m][k >> 2][k & 3]; g[k] = geluf_(uu) * bv[k]; }
                    if (!defer) st8bf(wsp<bf16>(p, WS_G) + (long)row * DFF + c, g);
                    const bool first2 = (ai == 0 && wr == 0 && m == 0 && fr < 2), last2 = (ai == 1 && wr == 1 && m == 3 && fr >= 14);
                    if (first2 || last2) st8bf(wsp<bf16>(p, WS_FA) + (long)row * DFF + c, av);
                    if (first2) st8bf(wsp<bf16>(p, WS_FB) + (long)row * DFF + c, bv);
                    if (last2) { const RowInfo ri = rowinfo(row); if (ri.t >= T - 2) { float* o = p.out + O_CONVP + (((long)l * NB + ri.b) * 2 + (ri.t - (T - 2))) * DFF + c;
#pragma unroll
                            for (int k = 0; k < 8; ++k) o[k] = av[k]; } }
                }
            asm volatile("s_waitcnt lgkmcnt(0)\n\ts_barrier" ::: "memory");
            return;
        }
#endif
        EPI_BEGIN { const int c = u.pn * 128 + wc * 32 + fq * 8; const RowInfo ri = rowinfo(row);
            if (fused) { const float rs = rsv[ai][m]; f32x4 h0 = bj == 0 ? ha0 : hb0, h1 = bj == 0 ? ha1 : hb1;
                if (!uni) { const float* sh = wsp<float>(p, WS_SHP) + ((long)l * 64 + ri.modrow) * NINP + col; h0 = *(const f32x4*)sh; h1 = *(const f32x4*)(sh + 4); }
#pragma unroll
                for (int k = 0; k < 4; ++k) { v[k] = v[k] * rs + h0[k]; v[4 + k] = v[4 + k] * rs + h1[k]; } }
            st8bf(wsp<bf16>(p, bj == 0 ? WS_FA : WS_FB) + (long)row * DFF + c, v);
            if (bj == 0) { float* o = nullptr;
                if (ri.kind == 0 && ri.t >= T - 2) o = p.out + O_CONVP + (((long)l * NB + ri.b) * 2 + (ri.t - (T - 2))) * DFF + c;
                if (ri.kind == 1 && ri.t >= DS - 2) o = p.out + O_CONVS + (((long)l * DB + ri.b) * 2 + (ri.t - (DS - 2))) * DFF + c;
                if (o) {
#pragma unroll
                    for (int k = 0; k < 8; ++k) o[k] = v[k]; } } } EPI_END
    }
};

constexpr int PH_PER_LAYER = 16, N_PHASES = 2 + DEPTH * PH_PER_LAYER;

#ifndef HOST_SIM
constexpr int NTHR_ = 512;
#define LAS __attribute__((address_space(3)))
namespace pg8 {
#define PG8_LAS __attribute__((address_space(3)))
typedef unsigned short bf16_t;
typedef short bf16x8 __attribute__((ext_vector_type(8)));
constexpr int BM = 256, BK = 64, HALF = 128, HTB = HALF * BK * 2, STAGE_BYTES = 8 * HTB, NXCD = 8, WGM = 8;
__host__ __device__ __forceinline__ int lds_byte(int r, int c) { const int st = (r >> 4) * 2 + (c >> 5), rr = r & 15, cc = c & 31, ob = rr * 64 + cc * 2; return st * 1024 + (ob ^ (((ob >> 9) & 1) << 5)); }
__host__ __device__ __forceinline__ void stage_rc(int b, int& R, int& C) { const int st = b / 1024, sb = b % 1024, swz = sb ^ (((sb >> 9) & 1) << 5); R = (st >> 1) * 16 + swz / 64; C = (st & 1) * 32 + (swz % 64) / 2; }
__host__ __device__ __forceinline__ int perm32(int rho) { const int n = rho >> 4, i = rho & 15; return 8 * (i >> 2) + 4 * n + (i & 3); }
struct Gemm { const bf16_t* A; const bf16_t* Bt; int M, N, K; };
struct StaticOrder {
    int nM, nN, nwg, G, c;
    __host__ __device__ void init(int M, int N, int G_, int c_) { nM = M / BM; nN = N / BM; nwg = nM * nN; G = G_; c = c_; }
    __host__ __device__ bool next(int i, Unit& u) const {
        const long L = (long)i * G + c; if (L >= nwg) return false;
        int wgid = (int)L; { const int q = nwg / NXCD, r = nwg % NXCD, xcd = wgid % NXCD, off = wgid / NXCD; wgid = (xcd < r ? xcd * (q + 1) : r * (q + 1) + (xcd - r) * q) + off; }
        const int nig = WGM * nN, gid = wgid / nig, fm = gid * WGM, gsz = (nM - fm) < WGM ? (nM - fm) : WGM;
        u.pm = fm + ((wgid % nig) % gsz); u.pn = (wgid % nig) / gsz; return true;
    }
    __device__ __forceinline__ void a_ready(const Unit&) const {}
    __device__ __forceinline__ void done(const Unit&) const {}
};
template <class Epi, class Sched, bool ALIGN_EPI = false, bool SP2 = false>
__device__ __forceinline__ void gemm_phase(PG8_LAS unsigned char* lds, const Gemm g, const Sched& S, const Epi& E) {
    int tid_ = threadIdx.x; asm volatile("" : "+v"(tid_));
    const int tid = tid_, wid = __builtin_amdgcn_readfirstlane(tid >> 6), lane = tid & 63, wr = wid >> 2, wc = wid & 3, fr = lane & 15, fq = lane >> 4;
    const int K = g.K, nt = K / BK;
    unsigned voffA[2], voffB[2];
#pragma unroll
    for (int i = 0; i < 2; ++i) { int R, C; stage_rc(tid * 16 + i * 8192, R, C); const int Rb = Epi::PERM ? ((R & ~31) + perm32(R & 31)) : R;
        voffA[i] = (unsigned)(R * K + C) * 2u; voffB[i] = (unsigned)(Rb * K + C) * 2u; }
    const size_t kstep = (size_t)(BK * 2);
    const size_t hstep = (size_t)HALF * K * 2;
    const size_t tstep = 2 * hstep;
    const unsigned ldsw = (unsigned)wid * 1024u;
    const int aoff = lds_byte(wr * 64 + fr, fq * 8), boff = lds_byte(wc * 32 + fr, fq * 8);
#define PG8_SA(b, h) (((b) * 2 + (h)) * HTB)
#define PG8_SB(b, h) ((4 + (b) * 2 + (h)) * HTB)
#define PG8_STAGE(bufoff, gbase, voff) do { _Pragma("unroll") for (int _i = 0; _i < 2; ++_i) \
        __builtin_amdgcn_global_load_lds((const unsigned*)((const char*)(gbase) + (voff)[_i]), (PG8_LAS unsigned*)(lds + (bufoff) + ldsw + _i * 8192), 16, 0, 0); } while (0)
#define PG8_LDA(dst, b, h) do { _Pragma("unroll") for (int m = 0; m < 4; ++m) _Pragma("unroll") for (int k = 0; k < 2; ++k) dst[m][k] = *(const PG8_LAS bf16x8*)(lds + PG8_SA(b, h) + aoff + m * 2048 + k * 1024); } while (0)
#define PG8_LDB(dst, b, h) do { _Pragma("unroll") for (int n = 0; n < 2; ++n) _Pragma("unroll") for (int k = 0; k < 2; ++k) dst[n][k] = *(const PG8_LAS bf16x8*)(lds + PG8_SB(b, h) + boff + n * 2048 + k * 1024); } while (0)
#define PG8_MMA(ai, bj, At, Bt) do { __builtin_amdgcn_s_setprio(1); _Pragma("unroll") for (int m = 0; m < 4; ++m) _Pragma("unroll") for (int n = 0; n < 2; ++n) _Pragma("unroll") for (int k = 0; k < 2; ++k) \
        acc[ai][bj][m][n] = __builtin_amdgcn_mfma_f32_16x16x32_bf16(Bt[n][k], At[m][k], acc[ai][bj][m][n], 0, 0, 0); __builtin_amdgcn_s_setprio(0); } while (0)
#define PG8_WAIT_V(n) asm volatile("s_waitcnt vmcnt(" #n ")" ::: "memory")
#define PG8_WAIT_L(n) asm volatile("s_waitcnt lgkmcnt(" #n ")" ::: "memory")
#define PG8_BAR __builtin_amdgcn_s_barrier()
#define PG8_SCHED __builtin_amdgcn_sched_barrier(0)
    Unit cur, nxt; int ui = 0;
    if (!S.next(0, cur)) return;
    f32x4 acc[2][2][4][2];
#pragma unroll
    for (int a = 0; a < 2; ++a)
#pragma unroll
        for (int b = 0; b < 2; ++b)
#pragma unroll
            for (int m = 0; m < 4; ++m)
#pragma unroll
                for (int n = 0; n < 2; ++n) acc[a][b][m][n] = (f32x4){0.f, 0.f, 0.f, 0.f};
    bf16x8 At[4][2], B0[2][2], B1[2][2];
    const char* cA = (const char*)g.A + (size_t)cur.pm * tstep; const char* cB = (const char*)g.Bt + (size_t)cur.pn * tstep;
    S.a_ready(cur);
    if constexpr (SP2) {
        PG8_STAGE(PG8_SB(0, 0), cB, voffB); PG8_STAGE(PG8_SB(0, 1), cB + hstep, voffB); PG8_STAGE(PG8_SA(0, 0), cA, voffA); PG8_STAGE(PG8_SA(0, 1), cA + hstep, voffA);
        if (wr == 1) PG8_BAR;
        PG8_WAIT_V(2); PG8_BAR;
        PG8_STAGE(PG8_SB(1, 0), cB + kstep, voffB); PG8_STAGE(PG8_SA(1, 0), cA + kstep, voffA); PG8_STAGE(PG8_SB(1, 1), cB + hstep + kstep, voffB);
        PG8_WAIT_V(6); PG8_BAR;
    } else {
        PG8_STAGE(PG8_SB(0, 0), cB, voffB); PG8_STAGE(PG8_SA(0, 0), cA, voffA); PG8_STAGE(PG8_SB(0, 1), cB + hstep, voffB); PG8_STAGE(PG8_SA(0, 1), cA + hstep, voffA);
        if (wr == 1) PG8_BAR;
        PG8_WAIT_V(4); PG8_BAR;
        PG8_STAGE(PG8_SB(1, 0), cB + kstep, voffB); PG8_STAGE(PG8_SA(1, 0), cA + kstep, voffA); PG8_STAGE(PG8_SB(1, 1), cB + hstep + kstep, voffB);
        PG8_WAIT_V(6); PG8_BAR;
    }
    for (;;) {
        const bool has_next = S.next(ui + 1, nxt);
        const char* nA = has_next ? (const char*)g.A + (size_t)nxt.pm * tstep : cA; const char* nB = has_next ? (const char*)g.Bt + (size_t)nxt.pn * tstep : cB;
        for (int t = 0; t < nt; t += 2) {
            const bool last = (t == nt - 2);
            const char* a1 = cA + (size_t)(t + 1) * kstep;
            const char* a2 = last ? nA : cA + (size_t)(t + 2) * kstep; const char* b2 = last ? nB : cB + (size_t)(t + 2) * kstep;
            const char* a3 = a2 + kstep; const char* b3 = b2 + kstep;
            if (last && has_next) S.a_ready(nxt);
            if constexpr (SP2) {
            PG8_LDB(B0, 0, 0); PG8_LDB(B1, 0, 1); PG8_SCHED; PG8_LDA(At, 0, 0); PG8_STAGE(PG8_SA(1, 1), a1 + hstep, voffA);
            PG8_WAIT_V(8); PG8_WAIT_L(0); PG8_BAR; PG8_MMA(0, 0, At, B0); PG8_MMA(0, 1, At, B1); PG8_BAR; PG8_SCHED;
            PG8_LDA(At, 0, 1); PG8_STAGE(PG8_SB(0, 0), b2, voffB); PG8_STAGE(PG8_SB(0, 1), b2 + hstep, voffB); PG8_STAGE(PG8_SA(0, 0), a2, voffA);
            PG8_WAIT_V(8); PG8_WAIT_L(0); PG8_BAR; PG8_MMA(1, 0, At, B0); PG8_MMA(1, 1, At, B1); PG8_BAR; PG8_SCHED;
            PG8_LDB(B0, 1, 0); PG8_LDB(B1, 1, 1); PG8_SCHED; PG8_LDA(At, 1, 0); PG8_STAGE(PG8_SA(0, 1), a2 + hstep, voffA);
            PG8_WAIT_V(8); PG8_WAIT_L(0); PG8_BAR; PG8_MMA(0, 0, At, B0); PG8_MMA(0, 1, At, B1); PG8_BAR; PG8_SCHED;
            PG8_LDA(At, 1, 1); PG8_STAGE(PG8_SB(1, 0), b3, voffB); PG8_STAGE(PG8_SB(1, 1), b3 + hstep, voffB); PG8_STAGE(PG8_SA(1, 0), a3, voffA);
            PG8_WAIT_V(8); PG8_WAIT_L(0); PG8_BAR; PG8_MMA(1, 0, At, B0); PG8_MMA(1, 1, At, B1); PG8_BAR; PG8_SCHED;
            } else {
            PG8_LDB(B0, 0, 0); PG8_SCHED; PG8_LDA(At, 0, 0); PG8_STAGE(PG8_SA(1, 1), a1 + hstep, voffA);
            PG8_WAIT_L(8); PG8_BAR; PG8_WAIT_L(0); PG8_MMA(0, 0, At, B0); PG8_BAR; PG8_SCHED;
            PG8_LDB(B1, 0, 1); PG8_STAGE(PG8_SB(0, 0), b2, voffB);
            PG8_BAR; PG8_WAIT_L(0); PG8_MMA(0, 1, At, B1); PG8_BAR;
            PG8_LDA(At, 0, 1); PG8_STAGE(PG8_SA(0, 0), a2, voffA);
            PG8_BAR; PG8_WAIT_L(0); PG8_MMA(1, 0, At, B0); PG8_BAR; PG8_SCHED;
            PG8_STAGE(PG8_SB(0, 1), b2 + hstep, voffB);
            PG8_WAIT_V(6); PG8_BAR; PG8_MMA(1, 1, At, B1); PG8_BAR;
            PG8_LDB(B0, 1, 0); PG8_SCHED; PG8_LDA(At, 1, 0); PG8_STAGE(PG8_SA(0, 1), a2 + hstep, voffA);
            PG8_WAIT_L(8); PG8_BAR; PG8_WAIT_L(0); PG8_MMA(0, 0, At, B0); PG8_BAR; PG8_SCHED;
            PG8_LDB(B1, 1, 1); PG8_STAGE(PG8_SB(1, 0), b3, voffB);
            PG8_BAR; PG8_WAIT_L(0); PG8_MMA(0, 1, At, B1); PG8_BAR;
            PG8_LDA(At, 1, 1); PG8_STAGE(PG8_SA(1, 0), a3, voffA);
            PG8_BAR; PG8_WAIT_L(0); PG8_MMA(1, 0, At, B0); PG8_BAR; PG8_SCHED;
            PG8_STAGE(PG8_SB(1, 1), b3 + hstep, voffB);
            PG8_WAIT_V(6); PG8_BAR; PG8_MMA(1, 1, At, B1); PG8_BAR;
            }
        }
        if constexpr (ALIGN_EPI) { if (wr == 0) PG8_BAR; }
        if constexpr (!Epi::AFTER_DRAIN) { E(acc, cur, wr, wc, fr, fq); S.done(cur); }
        if (!has_next) break;
#pragma unroll
        for (int a = 0; a < 2; ++a)
#pragma unroll
            for (int b = 0; b < 2; ++b)
#pragma unroll
                for (int m = 0; m < 4; ++m)
#pragma unroll
                    for (int n = 0; n < 2; ++n) acc[a][b][m][n] = (f32x4){0.f, 0.f, 0.f, 0.f};
        cur = nxt; cA = nA; cB = nB; ++ui;
        if constexpr (ALIGN_EPI) { if (wr == 1) PG8_BAR; }
    }
    PG8_WAIT_V(0);
    if constexpr (!ALIGN_EPI) { if (wr == 0) PG8_BAR; }
    PG8_BAR;
#undef PG8_SA
#undef PG8_SB
#undef PG8_STAGE
#undef PG8_LDA
#undef PG8_LDB
#undef PG8_MMA
#undef PG8_WAIT_V
#undef PG8_WAIT_L
#undef PG8_BAR
#undef PG8_SCHED
}
}


#define LDS_BAR() asm volatile("s_waitcnt lgkmcnt(0)\n\ts_barrier" ::: "memory")
namespace fa {
typedef short bf16x8 __attribute__((ext_vector_type(8)));
typedef short s16x4 __attribute__((ext_vector_type(4)));
typedef short v4i16_t __attribute__((ext_vector_type(4)));
typedef float f32x16 __attribute__((ext_vector_type(16)));
typedef float f32x2_t __attribute__((ext_vector_type(2)));
typedef __bf16 bf16x2_t __attribute__((ext_vector_type(2)));
#define FA_LAS __attribute__((address_space(3)))
constexpr int K0 = 0, K1 = 8192, V0 = 16384, V1 = 24576, WSCR = 65536;
constexpr float MASKV = -3e30f, MINIT = -1e30f;
__device__ __forceinline__ int crow(int r, int hi) { return (r & 3) + 8 * (r >> 2) + 4 * hi; }
__device__ __forceinline__ float swapmax(float v) { auto rr = __builtin_amdgcn_permlane32_swap(__float_as_uint(v), __float_as_uint(v), false, false); return fmaxf(__uint_as_float(rr[0]), __uint_as_float(rr[1])); }
__device__ __forceinline__ float swapsum(float v) { auto rr = __builtin_amdgcn_permlane32_swap(__float_as_uint(v), __float_as_uint(v), false, false); return __uint_as_float(rr[0]) + __uint_as_float(rr[1]); }
__device__ __forceinline__ float partner(float v, int hi) { auto rr = __builtin_amdgcn_permlane32_swap(__float_as_uint(v), __float_as_uint(v), false, false); return hi ? __uint_as_float(rr[0]) : __uint_as_float(rr[1]); }
__device__ __forceinline__ unsigned cvtpk(float lo, float hi) { f32x2_t v = {lo, hi}; bf16x2_t b = __builtin_convertvector(v, bf16x2_t); return __builtin_bit_cast(unsigned, b); }
struct TileRegs { u32x4 k, v; };
__device__ __forceinline__ void tile_load(TileRegs& tr, const bf16* base, int wid, int lane) {
    tr.k = *(const u32x4*)(base + (long)lane * 256 + wid * 8);
    tr.v = *(const u32x4*)(base + 128 + (long)(16 * (wid & 3) + (lane >> 2)) * 256 + (wid >> 2) * 32 + (lane & 3) * 8);
}
__device__ __forceinline__ void tile_store(const TileRegs& tr, FA_LAS unsigned char* lds, int kb, int vb, int wid, int lane) {
    *(FA_LAS u32x4*)(lds + kb + wid * 1024 + lane * 16) = tr.k;
    *(FA_LAS u32x4*)(lds + vb + wid * 1024 + lane * 16) = tr.v;
}
__device__ __forceinline__ void qkt(f32x16& p0, f32x16& p1, FA_LAS const unsigned char* kslot, const bf16x8* qr, int r32, int hi) {
    FA_LAS const unsigned char* kb = kslot + hi * 1024 + r32 * 16;
#pragma unroll
    for (int r = 0; r < 16; ++r) { p0[r] = 0.f; p1[r] = 0.f; }
#pragma unroll
    for (int d0 = 0; d0 < 4; ++d0) {
        const bf16x8 b0 = *(FA_LAS const bf16x8*)(kb + d0 * 2048), b1 = *(FA_LAS const bf16x8*)(kb + d0 * 2048 + 512);
        p0 = __builtin_amdgcn_mfma_f32_32x32x16_bf16(b0, qr[d0], p0, 0, 0, 0);
        p1 = __builtin_amdgcn_mfma_f32_32x32x16_bf16(b1, qr[d0], p1, 0, 0, 0);
    }
}
__device__ __forceinline__ void pvt(f32x16* o, FA_LAS const unsigned char* vslot, int lane, int hi, const f32x16& p0, const f32x16& p1) {
    FA_LAS const unsigned char* vp = vslot + ((lane >> 4) & 1) * 32 + (lane & 3) * 8 + (4 * hi + ((lane & 15) >> 2)) * 64;
    u32x4 pw[4];
#pragma unroll
    for (int k = 0; k < 4; ++k) { pw[0][k] = cvtpk(p0[2 * k], p0[2 * k + 1]); pw[1][k] = cvtpk(p0[8 + 2 * k], p0[9 + 2 * k]); pw[2][k] = cvtpk(p1[2 * k], p1[2 * k + 1]); pw[3][k] = cvtpk(p1[8 + 2 * k], p1[9 + 2 * k]); }
#pragma unroll
    for (int d0 = 0; d0 < 2; ++d0)
#pragma unroll
        for (int ks = 0; ks < 4; ++ks) {
            const s16x4 lo = __builtin_bit_cast(s16x4, __builtin_amdgcn_ds_read_tr16_b64_v4i16((FA_LAS v4i16_t*)(vp + d0 * 4096 + ks * 1024)));
            const s16x4 hh = __builtin_bit_cast(s16x4, __builtin_amdgcn_ds_read_tr16_b64_v4i16((FA_LAS v4i16_t*)(vp + d0 * 4096 + ks * 1024 + 512)));
            const bf16x8 vf = (bf16x8){lo[0], lo[1], lo[2], lo[3], hh[0], hh[1], hh[2], hh[3]};
            o[d0] = __builtin_amdgcn_mfma_f32_32x32x16_bf16(vf, __builtin_bit_cast(bf16x8, pw[ks]), o[d0], 0, 0, 0);
        }
}
__device__ __forceinline__ void attn_prompt_unit(const Params& q, int b, int g, int ib, FA_LAS unsigned char* lds) {
    int tid_ = threadIdx.x; asm volatile("" : "+v"(tid_));
    const int tid = tid_, lane = tid & 63, r32 = lane & 31, hi = lane >> 5, wid = __builtin_amdgcn_readfirstlane(tid >> 6);
    const int tq = 8 * wid + (r32 >> 2), hq = r32 & 3, head = 4 * g + hq;
    const long m = (long)b * T + 64 * ib + tq;
    const bf16* qp = wsp<bf16>(q, WS_QB) + m * 512 + head * 64;
    bf16x8 qr[4];
#pragma unroll
    for (int d0 = 0; d0 < 4; ++d0) qr[d0] = *(const bf16x8*)(qp + 16 * d0 + 8 * hi);
    const float* agp = wsp<float>(q, WS_AG) + m * 32 + head * 3;
    const float gc = agp[0], gs = agp[1], gw = agp[2];
    f32x16 res[2];
#pragma unroll
    for (int r = 0; r < 16; ++r) { res[0][r] = 0.f; res[1][r] = 0.f; }
    FA_LAS unsigned char* wscr = lds + WSCR + wid * 2048;
    FA_LAS float* impb = (FA_LAS float*)wscr; FA_LAS unsigned* maskb = (FA_LAS unsigned*)(wscr + 1024);
    const bf16* kvs = wsp<bf16>(q, WS_KVS) + ((long)b * T) * 256 + g * 64;
    const bf16* kvw = wsp<bf16>(q, WS_KVW) + ((long)b * T) * 256 + g * 64;
    { const bf16* kc = wsp<bf16>(q, WS_KC) + (long)(b * 128) * 256 + g * 64;
      TileRegs t0, t1; tile_load(t0, kc, wid, lane); tile_load(t1, kc + 64 * 256, wid, lane);
      tile_store(t0, lds, K0, V0, wid, lane); tile_store(t1, lds, K1, V1, wid, lane); }
    __syncthreads();
    TileRegs nx; tile_load(nx, kvs, wid, lane);
    {
        f32x16 s[4]; qkt(s[0], s[1], lds + K0, qr, r32, hi); qkt(s[2], s[3], lds + K1, qr, r32, hi);
        const int qpos = 64 * ib + tq; const int nmax = qpos >= 31 ? ((qpos - 31) >> 4) : -1; const bool have = nmax >= 0;
        float mx = MASKV;
#pragma unroll
        for (int t4 = 0; t4 < 4; ++t4)
#pragma unroll
            for (int r = 0; r < 16; ++r) { const int n = 32 * t4 + crow(r, hi); const float v = n <= nmax ? s[t4][r] : MASKV; s[t4][r] = v; mx = fmaxf(mx, v); }
        mx = swapmax(mx);
        float ls = 0.f;
#pragma unroll
        for (int t4 = 0; t4 < 4; ++t4)
#pragma unroll
            for (int r = 0; r < 16; ++r) { const float e = have ? __builtin_amdgcn_exp2f(s[t4][r] - mx) : 0.f; s[t4][r] = e; ls += e; }
        ls = swapsum(ls);
        const float inv = have ? 1.f / ls : 0.f;
        if (ib >= 16) {
            float G[16], E[16];
#pragma unroll
            for (int t4 = 0; t4 < 4; ++t4)
#pragma unroll
                for (int a = 0; a < 4; ++a) { G[t4 * 4 + a] = ((s[t4][4 * a] + s[t4][4 * a + 1]) + (s[t4][4 * a + 2] + s[t4][4 * a + 3])) * inv; E[t4 * 4 + a] = s[t4][4 * a + 3] * inv; }
            float Ep[16];
#pragma unroll
            for (int k = 0; k < 16; ++k) Ep[k] = partner(E[k], hi);
#pragma unroll
            for (int k = 0; k < 16; ++k) { const float add = hi ? Ep[k] : (k > 0 ? Ep[k > 0 ? k - 1 : 0] : 0.f); G[k] += add; }
#pragma unroll
            for (int k = 0; k < 16; ++k) { G[k] += __shfl_xor(G[k], 1); G[k] += __shfl_xor(G[k], 2); }
            if (hq == 0) {
#pragma unroll
                for (int k = 0; k < 16; ++k) impb[(r32 >> 2) * 32 + 8 * (k >> 2) + 2 * (k & 3) + hi] = G[k]; }
        }
        f32x16 o[2];
#pragma unroll
        for (int r = 0; r < 16; ++r) { o[0][r] = 0.f; o[1][r] = 0.f; }
        pvt(o, lds + V0, lane, hi, s[0], s[1]); pvt(o, lds + V1, lane, hi, s[2], s[3]);
        const float sc = gc * inv;
#pragma unroll
        for (int r = 0; r < 16; ++r) { res[0][r] += o[0][r] * sc; res[1][r] += o[1][r] * sc; }
    }
    unsigned selmask;
    if (ib < 16) selmask = 0xffffffffu >> (31 - ib);
    else {
#pragma unroll 1
        for (int pass = 0; pass < 4; ++pass) { const int tl = 2 * pass + hi, j = r32; const float v = impb[tl * 32 + j]; int rank = 0;
            for (int jj = 1; jj <= ib - 2; ++jj) { const float t = impb[tl * 32 + jj]; rank += (t > v || (t == v && jj < j)) ? 1 : 0; }
            const bool forced = (j == 0) || (j == ib) || (j == ib - 1), cand = (j >= 1) && (j <= ib - 2);
            const bool sel = forced || (cand && rank < 13);
            const unsigned long long bal = __ballot(sel);
            if (lane == 0) { maskb[2 * pass] = (unsigned)bal; maskb[2 * pass + 1] = (unsigned)(bal >> 32); } }
        selmask = maskb[r32 >> 2];
    }
    const int nB = ib + 1, jw0 = ib >= 8 ? ib - 8 : 0, nT = nB + (ib - jw0 + 1);
    float mrun = MINIT, lrun = 0.f, lfold = 0.f; f32x16 o[2];
#pragma unroll
    for (int r = 0; r < 16; ++r) { o[0][r] = 0.f; o[1][r] = 0.f; }
#define FA_SRC(t1) ((t1) < nB ? kvs + (long)(64 * (t1)) * 256 : kvw + (long)(64 * (jw0 + (t1) - nB)) * 256)
#define FA_KS(t1) (((t1) & 3) * 16384)
#define FA_VS(t1) (((t1) & 3) * 16384 + 8192)
    TileRegs ny; tile_load(ny, FA_SRC(1), wid, lane);
    __syncthreads();
    tile_store(nx, lds, FA_KS(0), FA_VS(0), wid, lane); tile_store(ny, lds, FA_KS(1), FA_VS(1), wid, lane);
    if (2 < nT) tile_load(nx, FA_SRC(2), wid, lane);
    __syncthreads();
    f32x16 sc0, sc1; qkt(sc0, sc1, lds + FA_KS(0), qr, r32, hi);
    u32x4 pwp[4];
#pragma unroll
    for (int k = 0; k < 4; ++k) pwp[k] = (u32x4){0u, 0u, 0u, 0u};
#pragma unroll 1
    for (int t = 0; t < nT; ++t) {
        if (t + 2 < nT) { tile_store(nx, lds, FA_KS(t + 2), FA_VS(t + 2), wid, lane); if (t + 3 < nT) tile_load(nx, FA_SRC(t + 3), wid, lane); }
        if (t == nB) {
            lfold = lrun; mrun = MINIT; lrun = 0.f; }
        const bool isB = t < nB; const int j = isB ? t : jw0 + (t - nB);
        if (j == ib) { asm volatile("; diagonal tile" ::: "memory");
#pragma unroll
            for (int r = 0; r < 16; ++r) { const int key = crow(r, hi); if (key > tq) sc0[r] = MASKV; if (key + 32 > tq) sc1[r] = MASKV; } }
        if (!isB && ib >= 8 && j == jw0) { asm volatile("; oldest window tile" ::: "memory");
#pragma unroll
            for (int r = 0; r < 16; ++r) { const int key = crow(r, hi); if (key <= tq) sc0[r] = MASKV; if (key + 32 <= tq) sc1[r] = MASKV; } }
        const bool lanesel = isB ? ((selmask >> j) & 1u) != 0u : true;
        const int tn = t + 1 < nT ? t + 1 : t, tp = t >= 1 ? t - 1 : 0;
        FA_LAS const unsigned char* kb = lds + FA_KS(tn) + hi * 1024 + r32 * 16;
        FA_LAS const unsigned char* vp = lds + FA_VS(tp) + ((lane >> 4) & 1) * 32 + (lane & 3) * 8 + (4 * hi + ((lane & 15) >> 2)) * 64;
        bf16x8 kf[8];
#pragma unroll
        for (int d0 = 0; d0 < 4; ++d0) { kf[2 * d0] = *(FA_LAS const bf16x8*)(kb + d0 * 2048); kf[2 * d0 + 1] = *(FA_LAS const bf16x8*)(kb + d0 * 2048 + 512); }
        bf16x8 vf[8];
#pragma unroll
        for (int i = 0; i < 8; ++i) { const int d0 = i >> 2, ks = i & 3;
            const s16x4 lo = __builtin_bit_cast(s16x4, __builtin_amdgcn_ds_read_tr16_b64_v4i16((FA_LAS v4i16_t*)(vp + d0 * 4096 + ks * 1024)));
            const s16x4 hh = __builtin_bit_cast(s16x4, __builtin_amdgcn_ds_read_tr16_b64_v4i16((FA_LAS v4i16_t*)(vp + d0 * 4096 + ks * 1024 + 512)));
            vf[i] = (bf16x8){lo[0], lo[1], lo[2], lo[3], hh[0], hh[1], hh[2], hh[3]}; }
        f32x16 sn0, sn1;
#pragma unroll
        for (int r = 0; r < 16; ++r) { sn0[r] = 0.f; sn1[r] = 0.f; }
#pragma unroll
        for (int d0 = 0; d0 < 4; ++d0) { sn0 = __builtin_amdgcn_mfma_f32_32x32x16_bf16(kf[2 * d0], qr[d0], sn0, 0, 0, 0); sn1 = __builtin_amdgcn_mfma_f32_32x32x16_bf16(kf[2 * d0 + 1], qr[d0], sn1, 0, 0, 0); }
#pragma unroll
        for (int i = 0; i < 8; ++i) o[i >> 2] = __builtin_amdgcn_mfma_f32_32x32x16_bf16(vf[i], __builtin_bit_cast(bf16x8, pwp[i & 3]), o[i >> 2], 0, 0, 0);
        float mt = fmaxf(sc0[0], sc1[0]);
#pragma unroll
        for (int r = 1; r < 16; ++r) mt = fmaxf(mt, fmaxf(sc0[r], sc1[r]));
        mt = swapmax(mt); if (!lanesel) mt = MASKV;
        const float mnew = fmaxf(mrun, mt); const float msub = lanesel ? mnew : 3e38f; float ls = 0.f;
#pragma unroll
        for (int r = 0; r < 16; ++r) { sc0[r] = __builtin_amdgcn_exp2f(sc0[r] - msub); sc1[r] = __builtin_amdgcn_exp2f(sc1[r] - msub); ls += sc0[r] + sc1[r]; }
#pragma unroll
        for (int k = 0; k < 4; ++k) { pwp[0][k] = cvtpk(sc0[2 * k], sc0[2 * k + 1]); pwp[1][k] = cvtpk(sc0[8 + 2 * k], sc0[9 + 2 * k]); pwp[2][k] = cvtpk(sc1[2 * k], sc1[2 * k + 1]); pwp[3][k] = cvtpk(sc1[8 + 2 * k], sc1[9 + 2 * k]); }
        if (t == nB) { asm volatile("; fold" ::: "memory"); const float sc = gs / swapsum(lfold);
#pragma unroll
            for (int r = 0; r < 16; ++r) { res[0][r] += o[0][r] * sc; res[1][r] += o[1][r] * sc; o[0][r] = 0.f; o[1][r] = 0.f; } }
        if (__any(mnew > mrun)) { asm volatile("; rescale" ::: "memory"); const float alpha = __builtin_amdgcn_exp2f(mrun - mnew); lrun *= alpha;
#pragma unroll
            for (int r = 0; r < 16; ++r) { o[0][r] *= alpha; o[1][r] *= alpha; } }
        mrun = mnew; lrun += ls;
        sc0 = sn0; sc1 = sn1;
        LDS_BAR();
    }
    {
        FA_LAS const unsigned char* vp = lds + FA_VS(nT - 1) + ((lane >> 4) & 1) * 32 + (lane & 3) * 8 + (4 * hi + ((lane & 15) >> 2)) * 64;
#pragma unroll
        for (int d0 = 0; d0 < 2; ++d0)
#pragma unroll
            for (int ks = 0; ks < 4; ++ks) {
                const s16x4 lo = __builtin_bit_cast(s16x4, __builtin_amdgcn_ds_read_tr16_b64_v4i16((FA_LAS v4i16_t*)(vp + d0 * 4096 + ks * 1024)));
                const s16x4 hh = __builtin_bit_cast(s16x4, __builtin_amdgcn_ds_read_tr16_b64_v4i16((FA_LAS v4i16_t*)(vp + d0 * 4096 + ks * 1024 + 512)));
                const bf16x8 vf = (bf16x8){lo[0], lo[1], lo[2], lo[3], hh[0], hh[1], hh[2], hh[3]};
                o[d0] = __builtin_amdgcn_mfma_f32_32x32x16_bf16(vf, __builtin_bit_cast(bf16x8, pwp[ks]), o[d0], 0, 0, 0); }
        const float sc = gw / swapsum(lrun);
#pragma unroll
        for (int r = 0; r < 16; ++r) { res[0][r] += o[0][r] * sc; res[1][r] += o[1][r] * sc; }
    }
    LDS_BAR();
#undef FA_SRC
#undef FA_KS
#undef FA_VS
    bf16* op = wsp<bf16>(q, WS_OA) + m * 512 + head * 64;
#pragma unroll
    for (int d0 = 0; d0 < 2; ++d0)
#pragma unroll
        for (int a = 0; a < 4; ++a) { const unsigned w0 = cvtpk(res[d0][4 * a], res[d0][4 * a + 1]), w1 = cvtpk(res[d0][4 * a + 2], res[d0][4 * a + 3]);
            *(unsigned long long*)(op + 32 * d0 + 8 * a + 4 * hi) = (unsigned long long)w0 | ((unsigned long long)w1 << 32); }
}
__device__ __forceinline__ void attn_prompt_phase(const Params& q, FA_LAS unsigned char* lds) {
    const int G = gridDim.x, bx = blockIdx.x; const int vcu = (G % 8 == 0) ? (bx % 8) * (G / 8) + bx / 8 : bx;
    for (int u = vcu; u < NB * 2 * 16; u += G) { const int bg = u / 16, s = u % 16; attn_prompt_unit(q, bg / 2, bg % 2, s, lds); attn_prompt_unit(q, bg / 2, bg % 2, 31 - s, lds); }
}
}


namespace rt {
using fa::bf16x8; using fa::s16x4; using fa::v4i16_t; using fa::f32x16; using fa::cvtpk; using fa::crow;
__device__ __forceinline__ int tr_off(int row, int c8, int R16) { return ((c8 >> 2) * R16 + (row >> 4)) * 1024 + (row & 15) * 64 + (c8 & 3) * 16; }
__device__ __forceinline__ bf16x8 trfrag(FA_LAS const unsigned char* tile, int R16, int cb, int ks, int lane, int hi) {
    FA_LAS const unsigned char* vp = tile + (cb * R16 + ks) * 1024 + ((lane >> 4) & 1) * 32 + (lane & 3) * 8 + (4 * hi + ((lane & 15) >> 2)) * 64;
    const s16x4 lo = __builtin_bit_cast(s16x4, __builtin_amdgcn_ds_read_tr16_b64_v4i16((FA_LAS v4i16_t*)vp));
    const s16x4 hh = __builtin_bit_cast(s16x4, __builtin_amdgcn_ds_read_tr16_b64_v4i16((FA_LAS v4i16_t*)(vp + 512)));
    return (bf16x8){lo[0], lo[1], lo[2], lo[3], hh[0], hh[1], hh[2], hh[3]};
}
__device__ __forceinline__ int row_off(int row, int c8) { return row * 256 + ((c8 ^ (row & 7)) << 4); }
__device__ __forceinline__ float lg2h(int h) { return log2f(1.f - exp2f(-5.f - (float)h)); }
constexpr int QOFF = 0, KOFF = 32768, BOFF = 65536;
__device__ __forceinline__ void stage_rows(FA_LAS unsigned char* dst, const bf16* src, long pitch, int tid) {
#pragma unroll
    for (int i = 0; i < 4; ++i) { const int qd = tid + 512 * i, row = qd >> 4, c8 = qd & 15; *(FA_LAS u32x4*)(dst + row_off(row, c8)) = *(const u32x4*)(src + (long)row * pitch + c8 * 8); }
}
template <int W, bool SCALE> __device__ __forceinline__ void stage_tr(FA_LAS unsigned char* dst, const bf16* src, long pitch, int tid, float lg) {
    constexpr int C8 = W / 8;
#pragma unroll
    for (int i = 0; i < (128 * C8) / 512; ++i) { const int qd = tid + 512 * i, row = qd / C8, c8 = qd % C8; u32x4 v = *(const u32x4*)(src + (long)row * pitch + c8 * 8);
        if (SCALE) { const float f = __builtin_amdgcn_exp2f((float)(127 - row) * lg);
#pragma unroll
            for (int k = 0; k < 4; ++k) { const float a = __builtin_bit_cast(float, v[k] << 16) * f, b2 = __builtin_bit_cast(float, v[k] & 0xffff0000u) * f; v[k] = cvtpk(a, b2); } }
        *(FA_LAS u32x4*)(dst + tr_off(row, c8, 8)) = v; }
}
__device__ __forceinline__ void retU_unit(const Params& q, int u, FA_LAS unsigned char* lds) {
    int tid_ = threadIdx.x; asm volatile("" : "+v"(tid_));
    const int tid = tid_, lane = tid & 63, r32 = lane & 31, hi = lane >> 5, wid = __builtin_amdgcn_readfirstlane(tid >> 6);
    const int n = u % NCH, h = (u / NCH) % RH, b = u / (NCH * RH); const float lg = lg2h(h);
    const long row0 = (long)b * T + n * RC;
    stage_tr<128, true>(lds + QOFF, wsp<bf16>(q, WS_RK) + row0 * 512 + h * RDK, 512, tid, lg);
    stage_tr<256, false>(lds + BOFF, wsp<bf16>(q, WS_RV) + row0 * DM + h * RDV, DM, tid, 0.f);
    __syncthreads();
    const int dkt = wid & 3, dvh = wid >> 2;
    f32x16 acc[4];
#pragma unroll
    for (int t = 0; t < 4; ++t)
#pragma unroll
        for (int r = 0; r < 16; ++r) acc[t][r] = 0.f;
#pragma unroll
    for (int ks = 0; ks < 8; ++ks) { const bf16x8 bk = trfrag(lds + QOFF, 8, dkt, ks, lane, hi);
#pragma unroll
        for (int t = 0; t < 4; ++t) { const bf16x8 av = trfrag(lds + BOFF, 8, 4 * dvh + t, ks, lane, hi); acc[t] = __builtin_amdgcn_mfma_f32_32x32x16_bf16(av, bk, acc[t], 0, 0, 0); } }
    LDS_BAR();
    { FA_LAS unsigned char* ot = lds + (32 * dkt + r32) * 520;
#pragma unroll
      for (int t = 0; t < 4; ++t)
#pragma unroll
          for (int a = 0; a < 4; ++a) { const unsigned w0 = cvtpk(acc[t][4 * a], acc[t][4 * a + 1]), w1 = cvtpk(acc[t][4 * a + 2], acc[t][4 * a + 3]);
              *(FA_LAS unsigned long long*)(ot + (32 * (4 * dvh + t) + 8 * a + 4 * hi) * 2) = (unsigned long long)w0 | ((unsigned long long)w1 << 32); } }
    LDS_BAR();
    { bf16* U = wsp<bf16>(q, WS_RETU) + ((long)(b * RH + h) * NCH + n) * RDK * RDV;
#pragma unroll
      for (int i = 0; i < 8; ++i) { const int qd = tid + 512 * i, row = qd >> 5, c8 = qd & 31; const unsigned long long lo = *(FA_LAS const unsigned long long*)(lds + row * 520 + c8 * 16), hi2 = *(FA_LAS const unsigned long long*)(lds + row * 520 + c8 * 16 + 8);
          *(u32x4*)(U + (long)row * RDV + c8 * 8) = (u32x4){(unsigned)lo, (unsigned)(lo >> 32), (unsigned)hi2, (unsigned)(hi2 >> 32)}; } }
    LDS_BAR();
}
__device__ __forceinline__ void retO_fetch(const Params& q, int u, int tid, u32x4 (&pq)[4], u32x4 (&ps)[8]) {
    const int n = u % NCH, h = (u / NCH) % RH, b = u / (NCH * RH); const long row0 = (long)b * T + n * RC;
    const bf16* qsrc = wsp<bf16>(q, WS_RQ) + row0 * 512 + h * RDK; const bf16* ssrc = wsp<bf16>(q, WS_RETS) + ((long)(b * RH + h) * NCH + n) * RDK * RDV;
#pragma unroll
    for (int i = 0; i < 4; ++i) { const int qd = tid + 512 * i, row = qd >> 4, c8 = qd & 15; pq[i] = *(const u32x4*)(qsrc + (long)row * 512 + c8 * 8); }
#pragma unroll
    for (int i = 0; i < 8; ++i) { const int qd = tid + 512 * i, row = qd >> 5, c8 = qd & 31; ps[i] = *(const u32x4*)(ssrc + (long)row * RDV + c8 * 8); }
}
__device__ __forceinline__ void retO_unit(const Params& q, int l, int u, int unext, u32x4 (&pq)[4], u32x4 (&ps)[8], FA_LAS unsigned char* lds) {
    int tid_ = threadIdx.x; asm volatile("" : "+v"(tid_));
    const int tid = tid_, lane = tid & 63, r32 = lane & 31, hi = lane >> 5, wid = __builtin_amdgcn_readfirstlane(tid >> 6);
    const int n = u % NCH, h = (u / NCH) % RH, b = u / (NCH * RH); const float lg = lg2h(h);
    const long row0 = (long)b * T + n * RC;
#pragma unroll
    for (int i = 0; i < 4; ++i) { const int qd = tid + 512 * i, row = qd >> 4, c8 = qd & 15; *(FA_LAS u32x4*)(lds + QOFF + row_off(row, c8)) = pq[i]; }
#pragma unroll
    for (int i = 0; i < 8; ++i) { const int qd = tid + 512 * i, row = qd >> 5, c8 = qd & 31; *(FA_LAS u32x4*)(lds + BOFF + tr_off(row, c8, 8)) = ps[i]; }
    LDS_BAR();
    const int ct = wid & 3, dh = wid >> 2, c = 32 * ct + r32;
    u32x4 pk_[4], pv_[8];
    { const bf16* ksrc = wsp<bf16>(q, WS_RK) + row0 * 512 + h * RDK; const bf16* vsrc = wsp<bf16>(q, WS_RV) + row0 * DM + h * RDV;
#pragma unroll
      for (int i = 0; i < 4; ++i) { const int qd = tid + 512 * i, row = qd >> 4, c8 = qd & 15; pk_[i] = *(const u32x4*)(ksrc + (long)row * 512 + c8 * 8); }
#pragma unroll
      for (int i = 0; i < 8; ++i) { const int qd = tid + 512 * i, row = qd >> 5, c8 = qd & 31; pv_[i] = *(const u32x4*)(vsrc + (long)row * DM + c8 * 8); } }
    f32x16 acc[4];
#pragma unroll
    for (int t = 0; t < 4; ++t)
#pragma unroll
        for (int r = 0; r < 16; ++r) acc[t][r] = 0.f;
#pragma unroll
    for (int ks = 0; ks < 8; ++ks) {
        const unsigned long long q0 = *(FA_LAS const unsigned long long*)(lds + QOFF + row_off(c, 2 * ks) + 8 * hi), q1 = *(FA_LAS const unsigned long long*)(lds + QOFF + row_off(c, 2 * ks + 1) + 8 * hi);
        const u32x4 qq = (u32x4){(unsigned)q0, (unsigned)(q0 >> 32), (unsigned)q1, (unsigned)(q1 >> 32)}; const bf16x8 bq = __builtin_bit_cast(bf16x8, qq);
#pragma unroll
        for (int t = 0; t < 4; ++t) { const bf16x8 as = trfrag(lds + BOFF, 8, 4 * dh + t, ks, lane, hi); acc[t] = __builtin_amdgcn_mfma_f32_32x32x16_bf16(as, bq, acc[t], 0, 0, 0); } }
    const float qdec = __builtin_amdgcn_exp2f((float)(c + 1) * lg);
#pragma unroll
    for (int t = 0; t < 4; ++t)
#pragma unroll
        for (int r = 0; r < 16; ++r) acc[t][r] *= qdec;
    LDS_BAR();
#pragma unroll
    for (int i = 0; i < 4; ++i) { const int qd = tid + 512 * i, row = qd >> 4, c8 = qd & 15; *(FA_LAS u32x4*)(lds + KOFF + row_off(row, c8)) = pk_[i]; }
#pragma unroll
    for (int i = 0; i < 8; ++i) { const int qd = tid + 512 * i, row = qd >> 5, c8 = qd & 31; *(FA_LAS u32x4*)(lds + BOFF + tr_off(row, c8, 8)) = pv_[i]; }
    LDS_BAR();
    if (unext >= 0) retO_fetch(q, unext, tid, pq, ps);
    bf16x8 qf[8];
#pragma unroll
    for (int ks = 0; ks < 8; ++ks) qf[ks] = *(FA_LAS const bf16x8*)(lds + QOFF + row_off(c, 2 * ks + hi));
#pragma unroll 1
    for (int et = 0; et <= ct; ++et) {
        f32x16 st;
#pragma unroll
        for (int r = 0; r < 16; ++r) st[r] = 0.f;
#pragma unroll
        for (int ks = 0; ks < 8; ++ks) { const bf16x8 kf = *(FA_LAS const bf16x8*)(lds + KOFF + row_off(32 * et + r32, 2 * ks + hi)); st = __builtin_amdgcn_mfma_f32_32x32x16_bf16(kf, qf[ks], st, 0, 0, 0); }
#pragma unroll
        for (int r = 0; r < 16; ++r) { const int ee = 32 * et + crow(r, hi); st[r] = c >= ee ? st[r] * __builtin_amdgcn_exp2f((float)(c - ee) * lg) : 0.f; }
        u32x4 pw[2];
#pragma unroll
        for (int k = 0; k < 4; ++k) { pw[0][k] = cvtpk(st[2 * k], st[2 * k + 1]); pw[1][k] = cvtpk(st[8 + 2 * k], st[9 + 2 * k]); }
#pragma unroll
        for (int ks2 = 0; ks2 < 2; ++ks2)
#pragma unroll
            for (int t = 0; t < 4; ++t) { const bf16x8 av = trfrag(lds + BOFF, 8, 4 * dh + t, 2 * et + ks2, lane, hi); acc[t] = __builtin_amdgcn_mfma_f32_32x32x16_bf16(av, __builtin_bit_cast(bf16x8, pw[ks2]), acc[t], 0, 0, 0); }
    }
    u32x4 sgv[4]; const float* gw = q.in[I_GNW] + l * DM + h * RDV;
#pragma unroll
    for (int i = 0; i < 4; ++i) { const int qd = tid + 512 * i, row = qd >> 5, c8 = qd & 31; sgv[i] = *(const u32x4*)(wsp<bf16>(q, WS_SRG) + (row0 + row) * DM + h * RDV + c8 * 8); }
    float s1 = 0.f, s2 = 0.f;
#pragma unroll
    for (int t = 0; t < 4; ++t)
#pragma unroll
        for (int r = 0; r < 16; ++r) { s1 += acc[t][r]; s2 += acc[t][r] * acc[t][r]; }
    s1 = fa::swapsum(s1); s2 = fa::swapsum(s2);
    FA_LAS float* gst = (FA_LAS float*)(lds + 132096);
    if (hi == 0) { gst[((ct * 2 + dh) * 32 + r32) * 2] = s1; gst[((ct * 2 + dh) * 32 + r32) * 2 + 1] = s2; }
    __syncthreads();
    s1 += gst[((ct * 2 + (1 - dh)) * 32 + r32) * 2]; s2 += gst[((ct * 2 + (1 - dh)) * 32 + r32) * 2 + 1];
    const float mu = s1 * (1.f / RDV), var = fmaxf(s2 * (1.f / RDV) - mu * mu, 0.f), rs = 1.f / sqrtf(var + 1e-5f);
    LDS_BAR();
    { FA_LAS unsigned char* ot = lds + c * 520;
#pragma unroll
      for (int t = 0; t < 4; ++t)
#pragma unroll
          for (int a = 0; a < 4; ++a) { const unsigned w0 = cvtpk((acc[t][4 * a] - mu) * rs, (acc[t][4 * a + 1] - mu) * rs), w1 = cvtpk((acc[t][4 * a + 2] - mu) * rs, (acc[t][4 * a + 3] - mu) * rs);
              *(FA_LAS unsigned long long*)(ot + (32 * (4 * dh + t) + 8 * a + 4 * hi) * 2) = (unsigned long long)w0 | ((unsigned long long)w1 << 32); } }
    LDS_BAR();
    {
#pragma unroll
      for (int i = 0; i < 8; ++i) { const int qd = tid + 512 * i, row = qd >> 5, c8 = qd & 31; const long ro = (row0 + row) * DM + h * RDV + c8 * 8;
          const unsigned long long lo = *(FA_LAS const unsigned long long*)(lds + row * 520 + c8 * 16), hi2 = *(FA_LAS const unsigned long long*)(lds + row * 520 + c8 * 16 + 8);
          const u32x4 nv = (u32x4){(unsigned)lo, (unsigned)(lo >> 32), (unsigned)hi2, (unsigned)(hi2 >> 32)}, sg = i < 4 ? sgv[i < 4 ? i : 0] : *(const u32x4*)(wsp<bf16>(q, WS_SRG) + ro);
          const f32x4 g0 = *(const f32x4*)(gw + c8 * 8), g1 = *(const f32x4*)(gw + c8 * 8 + 4); u32x4 ov;
#pragma unroll
          for (int k = 0; k < 4; ++k) { const float ga = k < 2 ? g0[2 * k] : g1[2 * k - 4], gb = k < 2 ? g0[2 * k + 1] : g1[2 * k - 3];
              ov[k] = cvtpk(__builtin_bit_cast(float, nv[k] << 16) * __builtin_bit_cast(float, sg[k] << 16) * ga, __builtin_bit_cast(float, nv[k] & 0xffff0000u) * __builtin_bit_cast(float, sg[k] & 0xffff0000u) * gb); }
          *(u32x4*)(wsp<bf16>(q, WS_RO) + ro) = ov; } }
    LDS_BAR();
}
}


namespace cp {
using fa::bf16x8; using fa::f32x16; using fa::cvtpk; using fa::crow;
__device__ __forceinline__ void cmp_unit(const Params& q, int l, int u, FA_LAS unsigned char* lds) {
    int tid_ = threadIdx.x; asm volatile("" : "+v"(tid_));
    const int tid = tid_, lane = tid & 63, r32 = lane & 31, hi = lane >> 5, wid = __builtin_amdgcn_readfirstlane(tid >> 6);
    const int e = u & 1, part = u >> 1;
    const int chunk_l = 16 * wid + (r32 >> 1), g = r32 & 1;
    const float* bA; const float* bB; int crow0;
    if (part < NB) { bA = q.out + O_CMPP + (((long)l * NB + part) * T + (long)wid * 256) * 256; bB = bA + 128 * 256; crow0 = part * 128; }
    else { const int sb = (part - NB) >> 2, qt = (part - NB) & 3; const int* pt = (const int*)q.in[I_PT] + sb * NPAGES + qt * 16 + 2 * wid;
        const int pgA = __builtin_amdgcn_readfirstlane(pt[0]), pgB = __builtin_amdgcn_readfirstlane(pt[1]);
        bA = q.in[I_CCMP] + ((long)l * NPHYS + pgA) * PAGE * 256; bB = q.in[I_CCMP] + ((long)l * NPHYS + pgB) * PAGE * 256; crow0 = NB * 128 + sb * 512 + qt * 128; }
    const int lo = hi * 4096 + e * 128 + 4 * r32;
    const bf16* wt = wsp<bf16>(q, WS_W1T) + (size_t)(l * 2 + e) * 128 * 1024;
    FA_LAS unsigned char* stg = lds + 32768 + wid * 4096;
    const int wrow = 2 * hi + (r32 >> 4), wpc = (r32 & 15) >> 1, wofs = (r32 & 1) * 8;
    f32x16 acc[4];
#pragma unroll
    for (int t = 0; t < 4; ++t)
#pragma unroll
        for (int r = 0; r < 16; ++r) acc[t][r] = 0.f;
    u32x4 bn0[2], bn1[2]; f32x4 anA[8], anB[8];
    const int bnr = 16 * wid + (lane >> 3), bc8 = lane & 7;
#define CP_LOADB(bn, s_) do { _Pragma("unroll") for (int i_ = 0; i_ < 2; ++i_) bn[i_] = *(const u32x4*)(wt + (size_t)(bnr + 8 * i_) * 1024 + 64 * (s_) + 8 * bc8); } while (0)
#define CP_STOREB(bn, buf_) do { _Pragma("unroll") for (int i_ = 0; i_ < 2; ++i_) *(FA_LAS u32x4*)(lds + (buf_) * 16384 + bc8 * 2048 + (bnr + 8 * i_) * 16) = bn[i_]; } while (0)
#define CP_LOADA(an, s_) do { _Pragma("unroll") for (int i_ = 0; i_ < 8; ++i_) an[i_] = *(const f32x4*)((i_ < 4 ? bA : bB) + (i_ & 3) * 8192 + (s_) * 256 + lo); } while (0)
#define CP_SLAB(an, bnl, bns, s_) do { bf16x8 af[4]; \
        _Pragma("unroll") for (int i_ = 0; i_ < 8; ++i_) { const int row_ = 4 * i_ + wrow; \
            *(FA_LAS unsigned long long*)(stg + row_ * 128 + ((wpc ^ ((row_ >> 1) & 7)) * 16) + wofs) = (unsigned long long)cvtpk(an[i_][0], an[i_][1]) | ((unsigned long long)cvtpk(an[i_][2], an[i_][3]) << 32); } \
        if ((s_) + 2 < 16) { CP_LOADB(bnl, (s_) + 2); CP_LOADA(an, (s_) + 2); } \
        _Pragma("unroll") for (int k = 0; k < 4; ++k) af[k] = *(FA_LAS const bf16x8*)(stg + r32 * 128 + (((2 * k + hi) ^ ((r32 >> 1) & 7)) * 16)); \
        FA_LAS const unsigned char* bb = lds + ((s_) & 1) * 16384 + hi * 2048 + r32 * 16; \
        _Pragma("unroll") for (int k = 0; k < 4; ++k) _Pragma("unroll") for (int t = 0; t < 4; ++t) { const bf16x8 wf = *(FA_LAS const bf16x8*)(bb + k * 4096 + t * 512); acc[t] = __builtin_amdgcn_mfma_f32_32x32x16_bf16(wf, af[k], acc[t], 0, 0, 0); } \
        if ((s_) + 1 < 16) CP_STOREB(bns, ((s_) + 1) & 1); \
        LDS_BAR(); } while (0)
    CP_LOADB(bn0, 0); CP_LOADA(anA, 0); CP_LOADB(bn1, 1); CP_LOADA(anB, 1); CP_STOREB(bn0, 0);
    __syncthreads();
#pragma unroll 1
    for (int s_ = 0; s_ < 16; s_ += 2) { CP_SLAB(anA, bn0, bn1, s_); CP_SLAB(anB, bn1, bn0, s_ + 1); }
#undef CP_LOADB
#undef CP_STOREB
#undef CP_LOADA
#undef CP_SLAB
    float* P = wsp<float>(q, WS_PCMP) + ((long)(crow0 + chunk_l) * 4 + e * 2 + g) * 128;
#pragma unroll
    for (int t = 0; t < 4; ++t)
#pragma unroll
        for (int a = 0; a < 4; ++a) *(f32x4*)(P + 32 * t + 8 * a + 4 * hi) = (f32x4){acc[t][4 * a], acc[t][4 * a + 1], acc[t][4 * a + 2], acc[t][4 * a + 3]};
}
__device__ __forceinline__ void cmp_fin_wave(const Params& q, int l, int gwave, int ngw, int lane) {
    const int e = gwave & 1; const float* w2 = q.in[I_CW2] + ((long)l * 2 + e) * 64 * 64 + lane; float wc[64];
#pragma unroll
    for (int h = 0; h < 64; ++h) wc[h] = w2[h * 64];
    const float cbv = wsp<float>(q, WS_CB)[(l * 2 + e) * 64 + lane];
    const long nit = (long)CMPROWS * 2, stp = ngw >> 1;
    for (long it = gwave >> 1; it < nit; it += 2 * stp) {
        const long it2 = it + stp; const bool two = it2 < nit;
        const int crA = (int)(it >> 1), gA = (int)it & 1, crB = two ? (int)(it2 >> 1) : crA, gB = two ? (int)it2 & 1 : gA; int nA, nB2;
        const bool vA = cmp_row_valid(crA, nA), vB = cmp_row_valid(crB, nB2);
        const float* PA = wsp<float>(q, WS_PCMP) + ((long)crA * 4 + e * 2 + gA) * 128; const float* PB = wsp<float>(q, WS_PCMP) + ((long)crB * 4 + e * 2 + gB) * 128;
        const float a0 = PA[lane], a1 = PA[512 + 64 + lane], b0 = PB[lane], b1 = PB[512 + 64 + lane];
        const float hidA = vA ? geluf_(cbv + a0 + a1) : 0.f, hidB = vB ? geluf_(cbv + b0 + b1) : 0.f;
        float sA = 0.f, sB = 0.f;
#pragma unroll
        for (int h = 0; h < 64; ++h) { sA += __builtin_bit_cast(float, __builtin_amdgcn_readlane(__builtin_bit_cast(int, hidA), h)) * wc[h]; sB += __builtin_bit_cast(float, __builtin_amdgcn_readlane(__builtin_bit_cast(int, hidB), h)) * wc[h]; }
        wsp<bf16>(q, WS_KC)[(long)crA * 256 + e * 128 + gA * 64 + lane] = (bf16)f2bf(sA);
        if (two) wsp<bf16>(q, WS_KC)[(long)crB * 256 + e * 128 + gB * 64 + lane] = (bf16)f2bf(sB);
    }
}

__device__ __forceinline__ void cmp_fin_mfma(const Params& q, int l, int gwave, int ngw, int lane, int wave, FA_LAS unsigned char* lds) {
    const int e = gwave & 1, r32 = lane & 31, hi = lane >> 5; FA_LAS unsigned char* tile = lds + wave * 4096;
    const float* w2 = q.in[I_CW2] + ((long)l * 2 + e) * 64 * 64;
    bf16x8 bw[4][2];
#pragma unroll
    for (int ks = 0; ks < 4; ++ks)
#pragma unroll
        for (int nt = 0; nt < 2; ++nt) { float t8[8];
#pragma unroll
            for (int k = 0; k < 8; ++k) t8[k] = w2[(16 * ks + 8 * hi + k) * 64 + 32 * nt + r32];
            const u32x4 w = (u32x4){cvtpk(t8[0], t8[1]), cvtpk(t8[2], t8[3]), cvtpk(t8[4], t8[5]), cvtpk(t8[6], t8[7])}; bw[ks][nt] = __builtin_bit_cast(bf16x8, w); }
    const float cbv = wsp<float>(q, WS_CB)[(l * 2 + e) * 64 + lane];
    const long ngroups = (long)CMPROWS * 2 / 32;
    for (long gi = gwave >> 1; gi < ngroups; gi += ngw >> 1) {
        const long it0 = gi * 32; float pa[32], pb[32];
#pragma unroll
        for (int i = 0; i < 32; ++i) { const long it = it0 + i; const int cr = (int)(it >> 1), g = (int)it & 1; int nn; const bool v = cmp_row_valid(cr, nn);
            const float* P = wsp<float>(q, WS_PCMP) + ((long)cr * 4 + e * 2 + g) * 128; pa[i] = v ? P[lane] : 0.f; pb[i] = v ? P[512 + 64 + lane] : 0.f; }
#pragma unroll
        for (int i = 0; i < 32; ++i) { const long it = it0 + i; int nn; const bool v = cmp_row_valid((int)(it >> 1), nn);
            *(FA_LAS bf16*)(tile + (i * 64 + lane) * 2) = v ? (bf16)f2bf(geluf_(cbv + pa[i] + pb[i])) : (bf16)0; }
        f32x16 acc[2];
#pragma unroll
        for (int r = 0; r < 16; ++r) { acc[0][r] = 0.f; acc[1][r] = 0.f; }
#pragma unroll
        for (int ks = 0; ks < 4; ++ks) { const bf16x8 af = *(FA_LAS const bf16x8*)(tile + (r32 * 64 + 16 * ks + 8 * hi) * 2);
#pragma unroll
            for (int nt = 0; nt < 2; ++nt) acc[nt] = __builtin_amdgcn_mfma_f32_32x32x16_bf16(af, bw[ks][nt], acc[nt], 0, 0, 0); }
#pragma unroll
        for (int r = 0; r < 16; ++r) { const long it = it0 + crow(r, hi); const int cr = (int)(it >> 1), g = (int)it & 1; bf16* kc = wsp<bf16>(q, WS_KC) + (long)cr * 256 + e * 128 + g * 64 + r32;
            kc[0] = (bf16)f2bf(acc[0][r]); kc[32] = (bf16)f2bf(acc[1][r]); }
    }
}
static_assert(((long)CMPROWS * 2) % 32 == 0, "compress finalize groups");
}


namespace sa {
using fa::bf16x8; using fa::f32x16; using fa::cvtpk; using fa::crow; using fa::swapmax; using fa::swapsum; using fa::partner; using fa::qkt; using fa::pvt; using fa::MASKV; using fa::MINIT;
constexpr int EX = 132096, EX_STATS = EX, EX_EB = EX + 2048, EX_IMP = EX + 3072, EX_SEL = EX + 5248, EX_UL = EX + 5888, EX_UC = EX + 6416;
static_assert(EX_UC + 16 <= 147456, "LDS extra region");
__device__ __forceinline__ const char* uniform_ptr(const void* p) { const unsigned long long u = (unsigned long long)p;
    return (const char*)(((unsigned long long)(unsigned)__builtin_amdgcn_readfirstlane((int)(u >> 32)) << 32) | (unsigned)__builtin_amdgcn_readfirstlane((int)u)); }
__device__ __forceinline__ void wtile_bf16(FA_LAS unsigned char* slot, const bf16* base, int lane) {
    asm volatile("" : "+v"(lane));
    const int rsub = lane >> 3, c8 = lane & 7; const unsigned voff = (unsigned)(rsub * 256 + 8 * c8) * 2u; const char* ub = uniform_ptr(base);
    u32x4 kr[8], vr[8];
#pragma unroll
    for (int j = 0; j < 8; ++j) { kr[j] = *(const u32x4*)(ub + j * 4096 + voff); vr[j] = *(const u32x4*)(ub + 256 + j * 4096 + voff); }
    FA_LAS unsigned char* kd = slot + c8 * 1024; FA_LAS unsigned char* vd = slot + 8192 + (c8 >> 2) * 4096 + (c8 & 3) * 16;
#pragma unroll
    for (int j = 0; j < 8; ++j) { const int row = 8 * j + rsub; *(FA_LAS u32x4*)(kd + ((row ^ c8) * 16)) = kr[j]; }
#pragma unroll
    for (int j = 0; j < 8; ++j) { const int row = 8 * j + rsub; *(FA_LAS u32x4*)(vd + (row >> 4) * 1024 + (row & 15) * 64) = vr[j]; }
}
__device__ __forceinline__ void wtile_f32(FA_LAS unsigned char* slot, const float* base, int lane) {
    asm volatile("" : "+v"(lane));
    const int rsub = lane >> 4, c4 = lane & 15, c8 = c4 >> 1, hb = (c4 & 1) * 8; const unsigned voff = (unsigned)(rsub * 256 + 4 * c4) * 4u; const char* ub = uniform_ptr(base);
    f32x4 kr[16], vr[4];
#pragma unroll
    for (int j = 0; j < 16; ++j) kr[j] = *(const f32x4*)(ub + j * 4096 + voff);
#pragma unroll
    for (int j = 0; j < 4; ++j) vr[j] = *(const f32x4*)(ub + 512 + j * 4096 + voff);
    FA_LAS unsigned char* kd = slot + c8 * 1024 + hb; FA_LAS unsigned char* vd = slot + 8192 + (c8 >> 2) * 4096 + (c8 & 3) * 16 + hb;
#pragma unroll
    for (int j = 0; j < 16; ++j) { const int row = 4 * j + rsub; *(FA_LAS unsigned long long*)(kd + ((row ^ c8) * 16)) = (unsigned long long)cvtpk(kr[j][0], kr[j][1]) | ((unsigned long long)cvtpk(kr[j][2], kr[j][3]) << 32); }
#pragma unroll
    for (int j = 0; j < 12; ++j) kr[j] = *(const f32x4*)(ub + 512 + (4 + j) * 4096 + voff);
#pragma unroll
    for (int j = 0; j < 4; ++j) { const int row = 4 * j + rsub; *(FA_LAS unsigned long long*)(vd + (row >> 4) * 1024 + (row & 15) * 64) = (unsigned long long)cvtpk(vr[j][0], vr[j][1]) | ((unsigned long long)cvtpk(vr[j][2], vr[j][3]) << 32); }
#pragma unroll
    for (int j = 0; j < 12; ++j) { const int row = 4 * (4 + j) + rsub; *(FA_LAS unsigned long long*)(vd + (row >> 4) * 1024 + (row & 15) * 64) = (unsigned long long)cvtpk(kr[j][0], kr[j][1]) | ((unsigned long long)cvtpk(kr[j][2], kr[j][3]) << 32); }
}
__device__ __forceinline__ void qkt_sw(f32x16& p0, f32x16& p1, FA_LAS const unsigned char* kslot, const bf16x8* qr, int r32, int hi) {
#pragma unroll
    for (int r = 0; r < 16; ++r) { p0[r] = 0.f; p1[r] = 0.f; }
#pragma unroll
    for (int d0 = 0; d0 < 4; ++d0) { const int c8 = 2 * d0 + hi; FA_LAS const unsigned char* kb = kslot + c8 * 1024 + ((r32 ^ c8) * 16);
        const bf16x8 b0 = *(FA_LAS const bf16x8*)kb, b1 = *(FA_LAS const bf16x8*)(kb + 512);
        p0 = __builtin_amdgcn_mfma_f32_32x32x16_bf16(b0, qr[d0], p0, 0, 0, 0);
        p1 = __builtin_amdgcn_mfma_f32_32x32x16_bf16(b1, qr[d0], p1, 0, 0, 0);
    }
}
__device__ __forceinline__ void wstep(FA_LAS const unsigned char* slot, const bf16x8* qr, int lane, int r32, int hi, bool lanesel, int mode, int ts, float& mrun, float& lrun, f32x16* o) {
    f32x16 p0, p1; qkt_sw(p0, p1, slot, qr, r32, hi);
    if (mode == 1) {
#pragma unroll
        for (int r = 0; r < 16; ++r) { const int key = crow(r, hi); if (key > ts) p0[r] = MASKV; p1[r] = MASKV; } }
    if (mode == 2) {
#pragma unroll
        for (int r = 0; r < 16; ++r) { const int key = crow(r, hi); if (key <= ts) p0[r] = MASKV; } }
    float mt = fmaxf(p0[0], p1[0]);
#pragma unroll
    for (int r = 1; r < 16; ++r) mt = fmaxf(mt, fmaxf(p0[r], p1[r]));
    mt = swapmax(mt); if (!lanesel) mt = MASKV;
    const float mnew = fmaxf(mrun, mt), alpha = __builtin_amdgcn_exp2f(mrun - mnew);
    mrun = mnew; lrun *= alpha;
#pragma unroll
    for (int r = 0; r < 16; ++r) { o[0][r] *= alpha; o[1][r] *= alpha; }
    float ls = 0.f;
#pragma unroll
    for (int r = 0; r < 16; ++r) { float a = __builtin_amdgcn_exp2f(p0[r] - mnew), c = __builtin_amdgcn_exp2f(p1[r] - mnew); if (!lanesel) { a = 0.f; c = 0.f; } p0[r] = a; p1[r] = c; ls += a + c; }
    lrun += ls;
    pvt(o, slot + 8192, lane, hi, p0, p1);
}
__device__ __forceinline__ float wave_factor(FA_LAS unsigned char* lds, int wid, int r32, int hi, float mrun, float lrun) {
    FA_LAS float* st = (FA_LAS float*)(lds + EX_STATS);
    const float lt = swapsum(lrun);
    __syncthreads();
    if (hi == 0) { st[(wid * 32 + r32) * 2] = mrun; st[(wid * 32 + r32) * 2 + 1] = lt; }
    __syncthreads();
    float M = MINIT;
#pragma unroll
    for (int w = 0; w < 8; ++w) M = fmaxf(M, st[(w * 32 + r32) * 2]);
    float L = 0.f;
#pragma unroll
    for (int w = 0; w < 8; ++w) L += st[(w * 32 + r32) * 2 + 1] * __builtin_amdgcn_exp2f(st[(w * 32 + r32) * 2] - M);
    return L > 0.f ? __builtin_amdgcn_exp2f(mrun - M) / L : 0.f;
}
__device__ __forceinline__ void attn_sample_unit(const Params& q, int l, int sb, int g, FA_LAS unsigned char* lds) {
    int tid_ = threadIdx.x; asm volatile("" : "+v"(tid_));
    const int tid = tid_, lane = tid & 63, r32 = lane & 31, hi = lane >> 5, wid = __builtin_amdgcn_readfirstlane(tid >> 6);
    const int ts = (r32 & 15) >> 2, hq = r32 & 3, head = 4 * g + hq;
    const long m = (long)BT + sb * DS + ts;
    const bf16* qp = wsp<bf16>(q, WS_QB) + m * 512 + head * 64;
    bf16x8 qr[4];
#pragma unroll
    for (int d0 = 0; d0 < 4; ++d0) qr[d0] = *(const bf16x8*)(qp + 16 * d0 + 8 * hi);
    const float* agp = wsp<float>(q, WS_AG) + m * 32 + head * 3;
    const float gc = agp[0], gs = agp[1], gw = agp[2];
    FA_LAS unsigned char* slot = lds + wid * 16384;
    FA_LAS float* impb = (FA_LAS float*)(lds + EX_IMP); FA_LAS unsigned char* selb = lds + EX_SEL; FA_LAS int* ulist = (FA_LAS int*)(lds + EX_UL); FA_LAS int* ucnt = (FA_LAS int*)(lds + EX_UC);
    f32x16 res[2], o[2];
#pragma unroll
    for (int r = 0; r < 16; ++r) { res[0][r] = 0.f; res[1][r] = 0.f; o[0][r] = 0.f; o[1][r] = 0.f; }
    {
        wtile_bf16(slot, wsp<bf16>(q, WS_KC) + (long)(NB * 128 + sb * 512 + 64 * wid) * 256 + g * 64, lane);
        f32x16 p0, p1; qkt_sw(p0, p1, slot, qr, r32, hi);
        if (wid == 7 && hi == 1) p1[15] = MASKV;
        float mt = fmaxf(p0[0], p1[0]);
#pragma unroll
        for (int r = 1; r < 16; ++r) mt = fmaxf(mt, fmaxf(p0[r], p1[r]));
        const float mw = swapmax(mt); float ls = 0.f;
#pragma unroll
        for (int r = 0; r < 16; ++r) { p0[r] = __builtin_amdgcn_exp2f(p0[r] - mw); p1[r] = __builtin_amdgcn_exp2f(p1[r] - mw); ls += p0[r] + p1[r]; }
        const float f = wave_factor(lds, wid, r32, hi, mw, ls);
        float G[8], E[8];
#pragma unroll
        for (int a = 0; a < 4; ++a) { G[a] = ((p0[4 * a] + p0[4 * a + 1]) + (p0[4 * a + 2] + p0[4 * a + 3])) * f; E[a] = p0[4 * a + 3] * f; G[4 + a] = ((p1[4 * a] + p1[4 * a + 1]) + (p1[4 * a + 2] + p1[4 * a + 3])) * f; E[4 + a] = p1[4 * a + 3] * f; }
        FA_LAS float* eb = (FA_LAS float*)(lds + EX_EB);
        if (hi == 1) eb[wid * 32 + r32] = E[7];
        float Ep[8];
#pragma unroll
        for (int k = 0; k < 8; ++k) Ep[k] = partner(E[k], hi);
        __syncthreads();
        const float eprev = wid > 0 ? eb[(wid > 0 ? wid - 1 : 0) * 32 + r32] : 0.f;
#pragma unroll
        for (int k = 0; k < 8; ++k) { const float add = hi ? Ep[k] : (k > 0 ? Ep[k > 0 ? k - 1 : 0] : eprev); G[k] += add; }
#pragma unroll
        for (int k = 0; k < 8; ++k) { G[k] += __shfl_xor(G[k], 1); G[k] += __shfl_xor(G[k], 2); }
        if (hq == 0 && r32 < 16) {
#pragma unroll
            for (int k = 0; k < 8; ++k) impb[ts * 132 + 16 * wid + 8 * (k >> 2) + 2 * (k & 3) + hi] = G[k]; }
        pvt(o, slot + 8192, lane, hi, p0, p1);
        const float sc = gc * f;
#pragma unroll
        for (int r = 0; r < 16; ++r) { res[0][r] += o[0][r] * sc; res[1][r] += o[1][r] * sc; o[0][r] = 0.f; o[1][r] = 0.f; }
    }
    __syncthreads();
    { const int tk = tid >> 7, j = tid & 127; bool sel = (j == 0) || (j == 127);
      if (j >= 1 && j <= 126) { const float v = impb[tk * 132 + j]; int rank = 0;
          for (int jj = 1; jj <= 126; ++jj) { const float t = impb[tk * 132 + jj]; rank += (t > v || (t == v && jj < j)) ? 1 : 0; }
          sel = rank < 13; }
      selb[tk * 132 + j] = sel ? 1 : 0; if (j == 0) selb[tk * 132 + 128] = 1; }
    __syncthreads();
    if (wid == 0) {
        int cnt = 0;
#pragma unroll 1
        for (int base = 0; base < 192; base += 64) { const int j = base + lane; const bool any = j <= 128 && (selb[j] | selb[132 + j] | selb[264 + j] | selb[396 + j]);
            const unsigned long long bal = __ballot(any); const int pos = cnt + __builtin_popcountll(bal & ((1ull << lane) - 1ull)); if (any) ulist[pos] = j; cnt += __builtin_popcountll(bal); }
        if (lane == 0) *ucnt = cnt; }
    __syncthreads();
    float mrun = MINIT, lrun = 0.f;
    { const int nU = *ucnt; const int* pt = (const int*)q.in[I_PT] + sb * NPAGES;
#pragma unroll 1
      for (int it = wid; it < nU; it += 8) { const int j = ulist[it]; const bool lanesel = selb[ts * 132 + j] != 0;
          if (j < 128) { const int pg = pt[j >> 1]; wtile_f32(slot, q.in[I_CSEL] + (((long)l * NPHYS + pg) * PAGE + (j & 1) * 64) * 256 + g * 64, lane); wstep(slot, qr, lane, r32, hi, lanesel, 0, ts, mrun, lrun, o); }
          else { wtile_bf16(slot, wsp<bf16>(q, WS_KVS) + ((long)BT + sb * DS) * 256 + g * 64, lane); wstep(slot, qr, lane, r32, hi, lanesel, 1, ts, mrun, lrun, o); } } }
    { const float f = wave_factor(lds, wid, r32, hi, mrun, lrun), sc = gs * f;
#pragma unroll
      for (int r = 0; r < 16; ++r) { res[0][r] += o[0][r] * sc; res[1][r] += o[1][r] * sc; o[0][r] = 0.f; o[1][r] = 0.f; } }
    mrun = MINIT; lrun = 0.f;
    { wtile_f32(slot, q.in[I_SWIN] + (((long)l * DB + sb) * 512 + 64 * wid) * 256 + g * 64, lane); wstep(slot, qr, lane, r32, hi, true, wid == 0 ? 2 : 0, ts, mrun, lrun, o);
      if (wid == 0) { wtile_bf16(slot, wsp<bf16>(q, WS_KVW) + ((long)BT + sb * DS) * 256 + g * 64, lane); wstep(slot, qr, lane, r32, hi, true, 1, ts, mrun, lrun, o); } }
    { const float f = wave_factor(lds, wid, r32, hi, mrun, lrun), sc = gw * f;
#pragma unroll
      for (int r = 0; r < 16; ++r) { res[0][r] += o[0][r] * sc; res[1][r] += o[1][r] * sc; } }
    __syncthreads();
    { FA_LAS float* rs = (FA_LAS float*)slot;
      if (r32 < 16) {
#pragma unroll
          for (int d0 = 0; d0 < 2; ++d0)
#pragma unroll
              for (int a = 0; a < 4; ++a) *(FA_LAS f32x4*)(rs + r32 * 64 + 32 * d0 + 8 * a + 4 * hi) = (f32x4){res[d0][4 * a], res[d0][4 * a + 1], res[d0][4 * a + 2], res[d0][4 * a + 3]}; } }
    __syncthreads();
    { const int row = tid >> 5, d2 = (tid & 31) * 2; float s0 = 0.f, s1 = 0.f;
#pragma unroll
      for (int w = 0; w < 8; ++w) { const FA_LAS float* rs = (const FA_LAS float*)(lds + w * 16384); s0 += rs[row * 64 + d2]; s1 += rs[row * 64 + d2 + 1]; }
      const long mo = (long)BT + sb * DS + (row >> 2);
      *(unsigned*)(wsp<bf16>(q, WS_OA) + mo * 512 + (4 * g + (row & 3)) * 64 + d2) = cvtpk(s0, s1); }
    __syncthreads();
}
}


namespace sk {
using fa::bf16x8; using fa::f32x16; using fa::crow; using fa::cvtpk;
static_assert(NS % 32 == 0 && NS / 32 * 32 <= 256, "sample rows in 32-row tiles");
constexpr int NT = (NS / 32) * (DM / 32);
__device__ __forceinline__ f32x16 wave_part(const bf16* A, const bf16* Bt, int K, int row0, int col0, int wid, int r32, int hi) {
    f32x16 acc;
#pragma unroll
    for (int r = 0; r < 16; ++r) acc[r] = 0.f;
    const int kw = K / 8; const bf16* ap = A + (long)(row0 + r32) * K + wid * kw + 8 * hi; const bf16* bp = Bt + (long)(col0 + r32) * K + wid * kw + 8 * hi;
    const int nks = kw / 16;
#pragma unroll 1
    for (int k0 = 0; k0 < nks; k0 += 8) { bf16x8 a[8], b[8];
#pragma unroll
        for (int j = 0; j < 8; ++j) { const int ks = k0 + j < nks ? k0 + j : nks - 1; a[j] = *(const bf16x8*)(ap + 16 * ks); b[j] = *(const bf16x8*)(bp + 16 * ks); }
#pragma unroll
        for (int j = 0; j < 8; ++j) if (k0 + j < nks) acc = __builtin_amdgcn_mfma_f32_32x32x16_bf16(a[j], b[j], acc, 0, 0, 0); }
    return acc;
}
__device__ __forceinline__ void put_part(FA_LAS float* part, const f32x16& acc, int wid, int r32, int hi) {
#pragma unroll
    for (int r = 0; r < 16; ++r) part[(wid * 32 + crow(r, hi)) * 32 + r32] = acc[r];
}
__device__ __forceinline__ void mix_tile(const Params& q, int l, int tile, FA_LAS unsigned char* lds) {
    int tid_ = threadIdx.x; asm volatile("" : "+v"(tid_));
    const int tid = tid_, lane = tid & 63, r32 = lane & 31, hi = lane >> 5, wid = __builtin_amdgcn_readfirstlane(tid >> 6);
    const int row0 = BT + 32 * (tile / (DM / 32)), col0 = 32 * (tile % (DM / 32));
    const f32x16 pa = wave_part(wsp<bf16>(q, WS_OA), wsp<bf16>(q, WS_WTOA) + (size_t)l * DM * 512, 512, row0, col0, wid, r32, hi);
    const f32x16 pb = wave_part(wsp<bf16>(q, WS_RO), wsp<bf16>(q, WS_WTOB) + (size_t)l * DM * DM, DM, row0, col0, wid, r32, hi);
    FA_LAS float* PA = (FA_LAS float*)lds; FA_LAS float* PB = (FA_LAS float*)(lds + 32768);
    put_part(PA, pa, wid, r32, hi); put_part(PB, pb, wid, r32, hi);
    __syncthreads();
    { const int row = tid >> 4, c2 = (tid & 15) * 2; float a0 = 0.f, a1 = 0.f, b0 = 0.f, b1 = 0.f;
#pragma unroll
      for (int w = 0; w < 8; ++w) { a0 += PA[(w * 32 + row) * 32 + c2]; a1 += PA[(w * 32 + row) * 32 + c2 + 1]; b0 += PB[(w * 32 + row) * 32 + c2]; b1 += PB[(w * 32 + row) * 32 + c2 + 1]; }
      const long o = (long)(row0 + row) * DM + col0 + c2; const unsigned ga = *(const unsigned*)(wsp<bf16>(q, WS_SGA) + o), gb = *(const unsigned*)(wsp<bf16>(q, WS_SGB) + o);
      const float r0 = __builtin_bit_cast(float, ga << 16) * a0 + __builtin_bit_cast(float, gb << 16) * b0, r1 = __builtin_bit_cast(float, ga & 0xffff0000u) * a1 + __builtin_bit_cast(float, gb & 0xffff0000u) * b1;
      *(unsigned*)(wsp<bf16>(q, WS_MIX) + o) = cvtpk(r0, r1); }
    __syncthreads();
}
__device__ __forceinline__ void resid_tile(const Params& q, int l, const bf16* A, const bf16* Bt, int K, int goff, int nkind, int xin, int tile, FA_LAS unsigned char* lds) {
    int tid_ = threadIdx.x; asm volatile("" : "+v"(tid_));
    const int tid = tid_, lane = tid & 63, r32 = lane & 31, hi = lane >> 5, wid = __builtin_amdgcn_readfirstlane(tid >> 6);
    const int row0 = BT + 32 * (tile / (DM / 32)), col0 = 32 * (tile % (DM / 32));
    const f32x16 pa = wave_part(A, Bt, K, row0, col0, wid, r32, hi);
    FA_LAS float* PA = (FA_LAS float*)lds;
    put_part(PA, pa, wid, r32, hi);
    __syncthreads();
    { const int row = tid >> 4, c2 = (tid & 15) * 2; float a0 = 0.f, a1 = 0.f;
#pragma unroll
      for (int w = 0; w < 8; ++w) { a0 += PA[(w * 32 + row) * 32 + c2]; a1 += PA[(w * 32 + row) * 32 + c2 + 1]; }
      const int m = row0 + row, col = col0 + c2; const RowInfo ri = rowinfo(m); const float* g = wsp<float>(q, WS_MOD) + ((long)l * NMODROW + ri.modrow) * 6144 + goff + col; float* x = wsp<float>(q, WS_X) + (long)m * DM + col;
      const float* xs = xin ? q.in[I_XS] + (long)(m - BT) * DM + col : x;
      const float y0 = xs[0] + g[0] * a0, y1 = xs[1] + g[1] * a1; x[0] = y0; x[1] = y1;
      if (nkind >= 0) { const float* nw = fuse_nw(q, l, nkind) + col; const float* sc = fuse_sc(q, l, nkind, ri.modrow) + col;
          *(unsigned*)(wsp<bf16>(q, WS_XN) + (long)m * DM + col) = cvtpk(y0 * nw[0] * (1.f + sc[0]), y1 * nw[1] * (1.f + sc[1]));
          float ssq = y0 * y0 + y1 * y1; ssq += __shfl_xor(ssq, 1); ssq += __shfl_xor(ssq, 2); ssq += __shfl_xor(ssq, 4); ssq += __shfl_xor(ssq, 8);
          if ((tid & 15) == 0) wsp<float>(q, WS_SSP)[(long)m * 32 + (tile % (DM / 32))] = ssq; } }
    __syncthreads();
}
__device__ __forceinline__ void shp_task(const Params& q, int task, int lane) {
    const int r32 = lane & 31, hi = lane >> 5;
    constexpr int CT_F = NFI / 32, CT_I = NINP / 32; int which, rem = task;
    if (rem < 2 * CT_F) which = 0; else if (rem < 4 * CT_F) { which = 1; rem -= 2 * CT_F; } else { which = 2; rem -= 4 * CT_F; }
    const int nct = which == 2 ? CT_I : CT_F, rt = rem / nct, col0 = 32 * (rem % nct);
    const int r = 32 * rt + r32; const bool rv = r < NMODROW;
    const float* sh = which == 2 ? wsp<float>(q, WS_MOD) + ((long)1 * NMODROW + (rv ? r : 0)) * 6144 : wsp<float>(q, WS_MOD) + ((long)which * NMODROW + (rv ? r : 0)) * 6144 + 3072;
    const bf16* w = (which == 2 ? wsp<bf16>(q, WS_WTIN) + (size_t)1 * NINP * DM : wsp<bf16>(q, WS_WTFI) + (size_t)which * NFI * DM) + (size_t)(col0 + r32) * DM + 8 * hi;
    f32x16 acc;
#pragma unroll
    for (int k = 0; k < 16; ++k) acc[k] = 0.f;
#pragma unroll 8
    for (int ks = 0; ks < DM / 16; ++ks) { const f32x4 s0 = *(const f32x4*)(sh + 16 * ks + 8 * hi), s1 = *(const f32x4*)(sh + 16 * ks + 8 * hi + 4);
        u32x4 aw = (u32x4){cvtpk(s0[0], s0[1]), cvtpk(s0[2], s0[3]), cvtpk(s1[0], s1[1]), cvtpk(s1[2], s1[3])}; if (!rv) aw = (u32x4){0u, 0u, 0u, 0u};
        acc = __builtin_amdgcn_mfma_f32_32x32x16_bf16(__builtin_bit_cast(bf16x8, aw), *(const bf16x8*)(w + 16 * ks), acc, 0, 0, 0); }
#pragma unroll
    for (int k = 0; k < 16; ++k) { const int rr = 32 * rt + crow(k, hi); if (rr < NMODROW) wsp<float>(q, WS_SHP)[((long)which * 64 + rr) * NINP + col0 + r32] = acc[k]; }
}
constexpr int SHP_TASKS = 2 * (2 * (NFI / 32) + NINP / 32);
}

#define GASP __attribute__((address_space(1)))
__device__ __forceinline__ float wave_sum(float v) {
#pragma unroll
    for (int o = 1; o < 64; o <<= 1) v += __shfl_xor(v, o);
    return v;
}
__device__ __forceinline__ const float* norm_src(const Params& p, int l, int which, int m, const RowInfo& ri) {
    if (which == 0 && l == 0) return ri.kind == 0 ? p.in[I_XP] + (long)m * DM : p.in[I_XS] + (long)(m - BT) * DM;
    return wsp<float>(p, WS_X) + (long)m * DM; }
__device__ __forceinline__ void norm_finish(const Params& p, int l, int which, int m, const RowInfo& ri, const f32x4 (&v)[4], float ss, int lane) {
    bf16* xn = wsp<bf16>(p, WS_XN) + (long)m * DM; float* X = wsp<float>(p, WS_X) + (long)m * DM;
    const float rs = 1.f / sqrtf(wave_sum(ss) * (1.f / DM) + 1e-6f);
    if (which == 2) { float* y = ri.kind == 0 ? p.out + O_YP + (long)m * DM : p.out + O_YS + (long)(m - BT) * DM; const float* w = p.in[I_NFW];
#pragma unroll
        for (int j = 0; j < 4; ++j) { const f32x4 wv = *(const f32x4*)(w + 256 * j + 4 * lane); *(f32x4*)(y + 256 * j + 4 * lane) = v[j] * rs * wv; }
        return; }
    const float* w = (which == 0 ? p.in[I_N1W] : p.in[I_N2W]) + l * DM; const float* mod = wsp<float>(p, WS_MOD) + ((long)l * NMODROW + ri.modrow) * 6144 + (which == 0 ? 0 : 3072);
#pragma unroll
    for (int j = 0; j < 4; ++j) { const int c = 256 * j + 4 * lane; const f32x4 wv = *(const f32x4*)(w + c), sh = *(const f32x4*)(mod + c), sc = *(const f32x4*)(mod + 1024 + c);
        const f32x4 h = v[j] * rs * wv * (sc + 1.f) + sh;
        *(unsigned long long*)(xn + c) = (unsigned long long)pk2(h[0], h[1]) | ((unsigned long long)pk2(h[2], h[3]) << 32);
        (void)X; }
}
template <int NR> __device__ __forceinline__ void fast_norm_rows(const Params& p, int l, int which, int grp, int lane) {
    f32x4 v[NR][4]; RowInfo ri[NR];
#pragma unroll
    for (int k = 0; k < NR; ++k) { const int m = NR * grp + k; ri[k] = rowinfo(m < MP ? m : MP - 1); if (m >= MP) ri[k].kind = 3;
        if (ri[k].kind < 2) { const float* src = norm_src(p, l, which, m, ri[k]);
#pragma unroll
            for (int j = 0; j < 4; ++j) v[k][j] = *(const f32x4*)(src + 256 * j + 4 * lane); } }
#pragma unroll
    for (int k = 0; k < NR; ++k) { const int m = NR * grp + k;
        if (ri[k].kind < 2) { float ss = 0.f;
#pragma unroll
            for (int j = 0; j < 4; ++j) ss += (v[k][j][0] * v[k][j][0] + v[k][j][1] * v[k][j][1]) + (v[k][j][2] * v[k][j][2] + v[k][j][3] * v[k][j][3]);
            norm_finish(p, l, which, m, ri[k], v[k], ss, lane); }
        else if (ri[k].kind == 2 && which != 2) {
#pragma unroll
            for (int j = 0; j < 4; ++j) *(unsigned long long*)(wsp<bf16>(p, WS_XN) + (long)m * DM + 256 * j + 4 * lane) = 0ull; } }
}
constexpr int NORM_NR = 5;

__device__ __forceinline__ void fast_gn_row(const Params& p, int l, long item, int lane) {
    const long m = item / RH; const int h = (int)(item % RH); const long off = m * DM + h * RDV + 4 * lane;
    const f32x4 o = *(const f32x4*)(wsp<float>(p, WS_ORAW) + off);
    const float mu = wave_sum((o[0] + o[1]) + (o[2] + o[3])) * (1.f / RDV); const f32x4 d = o - mu;
    const float var = wave_sum((d[0] * d[0] + d[1] * d[1]) + (d[2] * d[2] + d[3] * d[3])) * (1.f / RDV); const float rs = 1.f / sqrtf(var + 1e-5f);
    const f32x4 w = *(const f32x4*)(p.in[I_GNW] + l * DM + h * RDV + 4 * lane); const unsigned long long sg = *(const unsigned long long*)(wsp<bf16>(p, WS_SRG) + off);
    const float r0 = bf2f((bf16)(sg & 0xffff)) * d[0] * rs * w[0], r1 = bf2f((bf16)((sg >> 16) & 0xffff)) * d[1] * rs * w[1], r2 = bf2f((bf16)((sg >> 32) & 0xffff)) * d[2] * rs * w[2], r3 = bf2f((bf16)(sg >> 48)) * d[3] * rs * w[3];
    *(unsigned long long*)(wsp<bf16>(p, WS_RO) + off) = (unsigned long long)pk2(r0, r1) | ((unsigned long long)pk2(r2, r3) << 32);
}
__device__ __forceinline__ void fast_wt_item(const float* W, int K, int Nsrc, bf16* WT, int k0, int n0, int sc, LAS float* scr, int lane) {
    float tv[32];
#pragma unroll
    for (int i = 0; i < 32; ++i) { const int kk = 2 * i + (lane >> 5); tv[i] = sc >= 0 ? W[(size_t)(k0 + kk) * Nsrc + sc] : 0.f; }
#pragma unroll
    for (int i = 0; i < 32; ++i) { const int kk = 2 * i + (lane >> 5); scr[kk * 33 + (lane & 31)] = tv[i]; }
    asm volatile("s_waitcnt lgkmcnt(0)" ::: "memory");
    const int c = lane & 7;
#pragma unroll
    for (int j = 0; j < 4; ++j) { const int n = (lane >> 3) + 8 * j; const LAS float* s = scr + (8 * c) * 33 + n;
        u32x4 o; o.x = pk2(s[0 * 33], s[1 * 33]); o.y = pk2(s[2 * 33], s[3 * 33]); o.z = pk2(s[4 * 33], s[5 * 33]); o.w = pk2(s[6 * 33], s[7 * 33]);
        *(u32x4*)(WT + (size_t)(n0 + n) * K + k0 + 8 * c) = o; }
    asm volatile("s_waitcnt lgkmcnt(0)" ::: "memory");
}
__device__ __forceinline__ void fast_prologue_weights(const Params& p, LAS unsigned char* lds, int gw, int ngw, int wave, int lane) {
    LAS float* scr = (LAS float*)(lds + wave * 16384);
    constexpr int I_IN = (DM / 64) * (NINP / 32), I_FI = (DM / 64) * (NFI / 32), I_OA = (512 / 64) * (DM / 32), I_OB = (DM / 64) * (DM / 32), I_O = I_OB, I_FO = (DFF / 64) * (DM / 32);
    constexpr int I_W1 = 4 * (1024 / 64) * (64 / 32);
    constexpr int PER_L = I_IN + I_FI + I_OA + I_OB + I_O + I_FO + I_W1;
    for (int it = gw; it < 2 * PER_L; it += ngw) {
        const int l = it / PER_L; int r = it % PER_L;
        if (r < I_IN) { const int nb = NINP / 32, kb = r / nb, n0 = 32 * (r % nb); fast_wt_item(p.in[I_WIN] + (size_t)l * DM * N_IN, DM, N_IN, wsp<bf16>(p, WS_WTIN) + (size_t)l * NINP * DM, 64 * kb, n0, win_srccol(n0 + (lane & 31)), scr, lane); continue; } r -= I_IN;
        if (r < I_FI) { const int nb = NFI / 32, kb = r / nb, n0 = 32 * (r % nb), n = n0 + (lane & 31); const int sc = ((n % 256) / 128) * DFF + (n / 256) * 128 + (n % 128);
            fast_wt_item(p.in[I_FWI] + (size_t)l * DM * NFI, DM, NFI, wsp<bf16>(p, WS_WTFI) + (size_t)l * NFI * DM, 64 * kb, n0, sc, scr, lane); continue; } r -= I_FI;
        if (r < I_OA) { const int nb = DM / 32, kb = r / nb, n0 = 32 * (r % nb); fast_wt_item(p.in[I_WOA] + (size_t)l * 512 * DM, 512, DM, wsp<bf16>(p, WS_WTOA) + (size_t)l * DM * 512, 64 * kb, n0, n0 + (lane & 31), scr, lane); continue; } r -= I_OA;
        if (r < I_OB) { const int nb = DM / 32, kb = r / nb, n0 = 32 * (r % nb); fast_wt_item(p.in[I_WOB] + (size_t)l * DM * DM, DM, DM, wsp<bf16>(p, WS_WTOB) + (size_t)l * DM * DM, 64 * kb, n0, n0 + (lane & 31), scr, lane); continue; } r -= I_OB;
        if (r < I_O) { const int nb = DM / 32, kb = r / nb, n0 = 32 * (r % nb); fast_wt_item(p.in[I_WO] + (size_t)l * DM * DM, DM, DM, wsp<bf16>(p, WS_WTO) + (size_t)l * DM * DM, 64 * kb, n0, n0 + (lane & 31), scr, lane); continue; } r -= I_O;
        if (r < I_FO) { const int nb = DM / 32, kb = r / nb, n0 = 32 * (r % nb); fast_wt_item(p.in[I_FWO] + (size_t)l * DFF * DM, DFF, DM, wsp<bf16>(p, WS_WTFO) + (size_t)l * DM * DFF, 64 * kb, n0, n0 + (lane & 31), scr, lane); continue; } r -= I_FO;
        { const int em = r / 32, rr = r % 32, kb = rr / 2, n0 = 32 * (rr % 2);
            fast_wt_item(p.in[I_CW1] + ((size_t)(l * 2 + (em >> 1)) * 2048 + (em & 1) * 1024) * 64, 1024, 64, wsp<bf16>(p, WS_W1T) + ((size_t)(l * 2 + (em >> 1)) * 128 + (em & 1) * 64) * 1024, 64 * kb, n0, n0 + (lane & 31), scr, lane); }
    }
}

__device__ __forceinline__ void fast_cb(const Params& p, LAS unsigned char* lds, int wave, int lane) {
    for (int le = (int)gridDim.x - 1 - (int)blockIdx.x; le >= 0 && le < 4; le += gridDim.x) {
        const float* pos = p.in[I_CPOS] + (long)le * 2048 + wave * 256; const float* w1 = p.in[I_CW1] + ((long)le * 2048 + wave * 256) * 64 + lane; float acc = 0.f;
#pragma unroll 16
        for (int k = 0; k < 256; ++k) acc += pos[k] * w1[(long)k * 64];
        LAS float* part = (LAS float*)lds; part[wave * 64 + lane] = acc;
        __syncthreads();
        if (wave == 0) { float s2 = 0.f;
#pragma unroll
            for (int w8 = 0; w8 < 8; ++w8) s2 += part[w8 * 64 + lane];
            wsp<float>(p, WS_CB)[le * 64 + lane] = s2; }
        __syncthreads();
    }
}

__device__ __forceinline__ void up8(const u32x4 w, float* f) {
#pragma unroll
    for (int k = 0; k < 4; ++k) { f[2 * k] = __builtin_bit_cast(float, w[k] << 16); f[2 * k + 1] = __builtin_bit_cast(float, w[k] & 0xffff0000u); } }
struct ConvIn { u32x4 a0, a1, a2, fb; };
struct ConvW { f32x4 c0[2], c1[2], c2[2], cb[2]; };
__device__ __forceinline__ void conv8_load(const Params& p, long item, ConvIn& ci) {
    const int m = (int)(item / (DFF / 8)), col = (int)(item % (DFF / 8)) * 8; const RowInfo ri = rowinfo(m);
    const bf16* fa = wsp<bf16>(p, WS_FA) + (long)m * DFF + col;
    ci.a0 = *(const u32x4*)fa; ci.fb = *(const u32x4*)(wsp<bf16>(p, WS_FB) + (long)m * DFF + col);
    ci.a1 = ri.t >= 1 ? *(const u32x4*)(fa - DFF) : (u32x4){0u, 0u, 0u, 0u}; ci.a2 = ri.t >= 2 ? *(const u32x4*)(fa - 2 * DFF) : (u32x4){0u, 0u, 0u, 0u};
}
__device__ __forceinline__ void conv8_finish(const Params& p, int l, long item, const ConvIn& ci, const ConvW& w) {
    const int m = (int)(item / (DFF / 8)), col = (int)(item % (DFF / 8)) * 8; const RowInfo ri = rowinfo(m);
    float a0[8], a1[8], a2[8], fb[8]; up8(ci.a0, a0); up8(ci.a1, a1); up8(ci.a2, a2); up8(ci.fb, fb);
    if (ri.kind == 1 && ri.t < 2) {
        const float* pv1 = p.in[I_SCONV] + (((long)l * DB + ri.b) * 2 + 1) * DFF + col; const float* pv2 = p.in[I_SCONV] + (((long)l * DB + ri.b) * 2 + ri.t) * DFF + col;
#pragma unroll
        for (int k = 0; k < 8; ++k) { if (ri.t < 1) a1[k] = pv1[k]; a2[k] = pv2[k]; } }
    float o[8];
#pragma unroll
    for (int k = 0; k < 8; ++k) { const float u = w.cb[k >> 2][k & 3] + a2[k] * w.c0[k >> 2][k & 3] + a1[k] * w.c1[k >> 2][k & 3] + a0[k] * w.c2[k >> 2][k & 3]; o[k] = geluf_(u) * fb[k]; }
    st8bf(wsp<bf16>(p, WS_G) + (long)m * DFF + col, o);
}
constexpr long CONV_Q = (long)MREAL * (DFF / 8) / 4;
static_assert(((long)MREAL * (DFF / 8)) % 4 == 0 && CONV_Q % (DFF / 8) == 0, "conv items in column-aligned quarters");
__device__ __forceinline__ void fast_conv8x4(const Params& p, int l, long i) {
    ConvW w; { const int col = (int)(i % (DFF / 8)) * 8; const float* cw = p.in[I_FCW] + (long)l * 3 * DFF + col; const float* cb = p.in[I_FCB] + l * DFF + col;
#pragma unroll
        for (int hh = 0; hh < 2; ++hh) { w.c0[hh] = *(const f32x4*)(cw + 4 * hh); w.c1[hh] = *(const f32x4*)(cw + DFF + 4 * hh); w.c2[hh] = *(const f32x4*)(cw + 2 * DFF + 4 * hh); w.cb[hh] = *(const f32x4*)(cb + 4 * hh); } }
    ConvIn c[4];
#pragma unroll
    for (int k = 0; k < 4; ++k) conv8_load(p, i + k * CONV_Q, c[k]);
#pragma unroll
    for (int k = 0; k < 4; ++k) conv8_finish(p, l, i + k * CONV_Q, c[k], w);
}

constexpr long CONVFIX_P = (long)NB * (T / 256 - 1) * 2 * (DFF / 8), CONVFIX_N = CONVFIX_P + (long)NS * (DFF / 8);
__device__ __forceinline__ void fast_convfix(const Params& p, int l, long i) {
    long item;
    if (i < CONVFIX_P) { const long cg = i % (DFF / 8), r = i / (DFF / 8); const int rr = (int)(r & 1), tj = (int)(r >> 1) % (T / 256 - 1), b = (int)((r >> 1) / (T / 256 - 1)); item = ((long)b * T + (tj + 1) * 256 + rr) * (DFF / 8) + cg; }
    else item = (long)BT * (DFF / 8) + (i - CONVFIX_P);
    ConvW w; { const int col = (int)(item % (DFF / 8)) * 8; const float* cw = p.in[I_FCW] + (long)l * 3 * DFF + col; const float* cb = p.in[I_FCB] + l * DFF + col;
#pragma unroll
        for (int hh = 0; hh < 2; ++hh) { w.c0[hh] = *(const f32x4*)(cw + 4 * hh); w.c1[hh] = *(const f32x4*)(cw + DFF + 4 * hh); w.c2[hh] = *(const f32x4*)(cw + 2 * DFF + 4 * hh); w.cb[hh] = *(const f32x4*)(cb + 4 * hh); } }
    ConvIn ci; conv8_load(p, item, ci); conv8_finish(p, l, item, ci, w);
}
__device__ __forceinline__ void fast_retOs_gn(const Params& p, int l, long item, int lane) {
    const int h = (int)(item % RH), sr = (int)(item / RH), b = sr / DS, t = sr % DS; const long m = BT + sr; const float lg = retlg(h);
    const bf16* qv = wsp<bf16>(p, WS_RQ) + m * 512 + h * RDK; const float q0 = bf2f(qv[lane]), q1 = bf2f(qv[64 + lane]);
    float o[4] = {0.f, 0.f, 0.f, 0.f};
    for (int e = 0; e <= t; ++e) { const long me = BT + b * DS + e; const bf16* kv = wsp<bf16>(p, WS_RK) + me * 512 + h * RDK; const float sdot = wave_sum(q0 * bf2f(kv[lane]) + q1 * bf2f(kv[64 + lane])) * expf((float)(t - e) * lg);
        const bf16* vv = wsp<bf16>(p, WS_RV) + me * DM + h * RDV;
#pragma unroll
        for (int k = 0; k < 4; ++k) o[k] += sdot * bf2f(vv[64 * k + lane]); }
    const float* S0 = p.in[I_SRET] + ((((long)l * DB + b) * RH + h) * RDK) * RDV; const float qd = expf((float)(t + 1) * lg); float o2[4] = {0.f, 0.f, 0.f, 0.f};
#pragma unroll 32
    for (int d = 0; d < RDK; ++d) { const float qq = bf2f(qv[d]);
#pragma unroll
        for (int k = 0; k < 4; ++k) o2[k] += qq * S0[(long)d * RDV + 64 * k + lane]; }
#pragma unroll
    for (int k = 0; k < 4; ++k) o[k] += o2[k] * qd;
    const float mu = wave_sum((o[0] + o[1]) + (o[2] + o[3])) * (1.f / RDV); float var = 0.f;
#pragma unroll
    for (int k = 0; k < 4; ++k) { o[k] -= mu; var += o[k] * o[k]; }
    const float rs = 1.f / sqrtf(wave_sum(var) * (1.f / RDV) + 1e-5f);
#pragma unroll
    for (int k = 0; k < 4; ++k) { const long off = m * DM + h * RDV + 64 * k + lane; wsp<bf16>(p, WS_RO)[off] = (bf16)f2bf(bf2f(wsp<bf16>(p, WS_SRG)[off]) * o[k] * rs * p.in[I_GNW][l * DM + h * RDV + 64 * k + lane]); }
}

__device__ __forceinline__ void fast_retS8(const Params& p, int l, long item) {
    const int j8 = (int)(item % (RDV / 8)) * 8, ii = (int)(item / (RDV / 8)) % RDK, h = (int)(item / ((RDV / 8) * RDK)) % RH, b = (int)(item / ((RDV / 8) * RDK * RH));
    const float sdec = expf((float)RC * retlg(h));
    const long base = ((((long)b * RH + h) * NCH) * RDK + ii) * RDV + j8; const long stepn = (long)RDK * RDV;
    u32x4 uu[NCH];
#pragma unroll
    for (int n = 0; n < NCH; ++n) uu[n] = *(const u32x4*)(wsp<bf16>(p, WS_RETU) + base + n * stepn);
    float S[8]; float z0 = 0.f; asm volatile("" : "+v"(z0));
#pragma unroll
    for (int k = 0; k < 8; ++k) S[k] = z0;
#pragma unroll
    for (int n = 0; n < NCH; ++n) { st8bf(wsp<bf16>(p, WS_RETS) + base + n * stepn, S); float f[8]; up8(uu[n], f);
#pragma unroll
        for (int k = 0; k < 8; ++k) S[k] = S[k] * sdec + f[k]; }
    float* o = p.out + O_RETP + ((((long)l * NB + b) * RH + h) * RDK + ii) * RDV + j8;
    *(f32x4*)o = (f32x4){S[0], S[1], S[2], S[3]}; *(f32x4*)(o + 4) = (f32x4){S[4], S[5], S[6], S[7]};
}
constexpr int RETSS_U = 8;
constexpr long RETSS_Q = (long)DB * RH * RDK * (RDV / 4) / RETSS_U;
static_assert(((long)DB * RH * RDK * (RDV / 4)) % RETSS_U == 0, "retSs items in equal parts");
__device__ __forceinline__ void fast_retSs4x4(const Params& p, int l, long i0) {
    f32x4 S[RETSS_U]; float kk[RETSS_U][DS]; unsigned long long vv[RETSS_U][DS]; long idx[RETSS_U];
#pragma unroll
    for (int u = 0; u < RETSS_U; ++u) { const long item = i0 + u * RETSS_Q;
        const int j4 = (int)(item % (RDV / 4)) * 4, ii = (int)(item / (RDV / 4)) % RDK, h = (int)(item / ((RDV / 4) * RDK)) % RH, b = (int)(item / ((RDV / 4) * RDK * RH));
        idx[u] = ((((long)l * DB + b) * RH + h) * RDK + ii) * RDV + j4; S[u] = *(const f32x4*)(p.in[I_SRET] + idx[u]);
#pragma unroll
        for (int c = 0; c < DS; ++c) { const long mc = BT + b * DS + c; kk[u][c] = bf2f(wsp<bf16>(p, WS_RK)[mc * 512 + h * RDK + ii]); vv[u][c] = *(const unsigned long long*)(wsp<bf16>(p, WS_RV) + mc * DM + h * RDV + j4); } }
#pragma unroll
    for (int u = 0; u < RETSS_U; ++u) { const long item = i0 + u * RETSS_Q; const int h = (int)(item / ((RDV / 4) * RDK)) % RH; const float lg = retlg(h);
        f32x4 Sv = S[u] * expf((float)DS * lg);
#pragma unroll
        for (int c = 0; c < DS; ++c) { const float kc = kk[u][c] * expf((float)(DS - 1 - c) * lg); const unsigned long long v2 = vv[u][c];
            Sv[0] += kc * __builtin_bit_cast(float, (unsigned)v2 << 16); Sv[1] += kc * __builtin_bit_cast(float, (unsigned)v2 & 0xffff0000u);
            Sv[2] += kc * __builtin_bit_cast(float, (unsigned)(v2 >> 32) << 16); Sv[3] += kc * __builtin_bit_cast(float, (unsigned)(v2 >> 32) & 0xffff0000u); }
        *(f32x4*)(p.out + O_RETS + idx[u]) = Sv; }
}
__device__ __forceinline__ void fast_copywin(const Params& p, long item) {
    constexpr long PER = 508L * 256 / 4, TOT = 2L * DB * PER, Q = TOT / 4;
    f32x4 v[4];
#pragma unroll
    for (int k = 0; k < 4; ++k) { const long gidx = item + k * Q; const long lb = gidx / PER, r = gidx % PER; v[k] = *(const f32x4*)(p.in[I_SWIN] + lb * 512 * 256 + 4 * 256 + 4 * r); }
#pragma unroll
    for (int k = 0; k < 4; ++k) { const long gidx = item + k * Q; const long lb = gidx / PER, r = gidx % PER; *(f32x4*)(p.out + O_WINS + lb * 512 * 256 + 4 * r) = v[k]; }
}
static_assert((2L * DB * 508 * 256 / 4) % 4 == 0, "copywin quarters");

__device__ __forceinline__ void retOs_block(const Params& p, int l, LAS unsigned char* lds) {
    static_assert(DS == 4 && RDK == 128 && RDV == 256, "retOs_block shape");
    int tid_ = threadIdx.x; asm volatile("" : "+v"(tid_));
    const int lane = tid_ & 63, wave = __builtin_amdgcn_readfirstlane(tid_ >> 6);
    LAS float* part = (LAS float*)lds;
    for (int task = (int)blockIdx.x; task < DB * RH * 2; task += (int)gridDim.x) {
        const int tp = task & 1, h = (task >> 1) % RH, b = (task >> 1) / RH; const float lg = retlg(h); const long m0 = BT + (long)b * DS;
        const float* S0 = p.in[I_SRET] + ((((long)l * DB + b) * RH + h) * RDK + 16 * wave) * RDV + lane;
        float sv[16][4];
#pragma unroll
        for (int d = 0; d < 16; ++d)
#pragma unroll
            for (int k = 0; k < 4; ++k) sv[d][k] = S0[(long)d * RDV + 64 * k];
        const float qmine = bf2f(wsp<bf16>(p, WS_RQ)[(m0 + 2 * tp + ((lane >> 4) & 1)) * 512 + h * RDK + 16 * wave + (lane & 15)]);
        int pt = -1, pe = 0;
        if (tp == 0) { if (wave < 3) { pt = wave == 0 ? 0 : 1; pe = wave == 2 ? 1 : 0; } }
        else { if (wave < 3) { pt = 2; pe = wave; } else if (wave < 7) { pt = 3; pe = wave - 3; } }
        float o0[4] = {0.f, 0.f, 0.f, 0.f}, o1[4] = {0.f, 0.f, 0.f, 0.f};
        if (pt >= 0) { const bf16* qv = wsp<bf16>(p, WS_RQ) + (m0 + pt) * 512 + h * RDK; const bf16* kv = wsp<bf16>(p, WS_RK) + (m0 + pe) * 512 + h * RDK;
            const float sdot = wave_sum(bf2f(qv[lane]) * bf2f(kv[lane]) + bf2f(qv[64 + lane]) * bf2f(kv[64 + lane])) * expf((float)(pt - pe) * lg);
            const bf16* vv = wsp<bf16>(p, WS_RV) + (m0 + pe) * DM + h * RDV; const float c0 = (pt & 1) ? 0.f : sdot, c1 = (pt & 1) ? sdot : 0.f;
#pragma unroll
            for (int k = 0; k < 4; ++k) { const float vk = bf2f(vv[64 * k + lane]); o0[k] = c0 * vk; o1[k] = c1 * vk; } }
        float a0[4] = {0.f, 0.f, 0.f, 0.f}, a1[4] = {0.f, 0.f, 0.f, 0.f};
#pragma unroll
        for (int d = 0; d < 16; ++d) { const float q0 = __builtin_bit_cast(float, __builtin_amdgcn_readlane(__builtin_bit_cast(int, qmine), d)), q1 = __builtin_bit_cast(float, __builtin_amdgcn_readlane(__builtin_bit_cast(int, qmine), 16 + d));
#pragma unroll
            for (int k = 0; k < 4; ++k) { a0[k] += q0 * sv[d][k]; a1[k] += q1 * sv[d][k]; } }
        const float qd0 = expf((float)(2 * tp + 1) * lg), qd1 = expf((float)(2 * tp + 2) * lg);
#pragma unroll
        for (int k = 0; k < 4; ++k) { part[(wave * 2 + 0) * 256 + 64 * k + lane] = o0[k] + a0[k] * qd0; part[(wave * 2 + 1) * 256 + 64 * k + lane] = o1[k] + a1[k] * qd1; }
        const long m = m0 + 2 * tp + (wave & 1); float sg[4], gw[4];
        if (wave < 2) {
#pragma unroll
            for (int k = 0; k < 4; ++k) { sg[k] = bf2f(wsp<bf16>(p, WS_SRG)[m * DM + h * RDV + 64 * k + lane]); gw[k] = p.in[I_GNW][l * DM + h * RDV + 64 * k + lane]; } }
        __syncthreads();
        if (wave < 2) { float o[4];
#pragma unroll
            for (int k = 0; k < 4; ++k) { float acc = 0.f;
#pragma unroll
                for (int w = 0; w < 8; ++w) acc += part[(w * 2 + wave) * 256 + 64 * k + lane];
                o[k] = acc; }
            const float mu = wave_sum((o[0] + o[1]) + (o[2] + o[3])) * (1.f / RDV); float var = 0.f;
#pragma unroll
            for (int k = 0; k < 4; ++k) { o[k] -= mu; var += o[k] * o[k]; }
            const float rs = 1.f / sqrtf(wave_sum(var) * (1.f / RDV) + 1e-5f);
#pragma unroll
            for (int k = 0; k < 4; ++k) wsp<bf16>(p, WS_RO)[m * DM + h * RDV + 64 * k + lane] = (bf16)f2bf(sg[k] * o[k] * rs * gw[k]); }
        __syncthreads();
    }
}
__device__ __forceinline__ void fast_ada(const Params& p, LAS unsigned char* lds, int wave, int lane) {
    static_assert(NMODROW <= 40, "fast_ada row tiles");
    using fa::bf16x8; using fa::f32x16; using fa::cvtpk; using fa::crow;
    const int r32 = lane & 31, hi = lane >> 5;
    for (int slab = blockIdx.x; slab < 2 * 6144 / 64; slab += gridDim.x) {
        const int l = slab / 96, j0 = (slab % 96) * 64, k0 = wave * 128;
        LAS unsigned char* sl = lds + wave * 16384;
        { float cv[2][40];
#pragma unroll
          for (int r = 0; r < 40; ++r) if (r < NMODROW) { const float* c = (r < NB ? p.in[I_CP] + (long)r * DM : p.in[I_CS] + (long)(r - NB) * DM) + k0; cv[0][r] = c[lane]; cv[1][r] = c[64 + lane]; }
#pragma unroll
          for (int r = 0; r < 40; ++r) if (r < NMODROW) { *(LAS bf16*)(sl + r * 256 + lane * 2) = (bf16)f2bf(siluf_(cv[0][r])); *(LAS bf16*)(sl + r * 256 + (64 + lane) * 2) = (bf16)f2bf(siluf_(cv[1][r])); } }
        f32x16 acc[2][2];
#pragma unroll
        for (int rt = 0; rt < 2; ++rt)
#pragma unroll
            for (int ct = 0; ct < 2; ++ct)
#pragma unroll
                for (int r = 0; r < 16; ++r) acc[rt][ct][r] = 0.f;
        const float* w = p.in[I_ADAW] + ((long)l * DM + k0 + 8 * hi) * 6144 + j0 + r32;
        float wn[2][8];
#pragma unroll
        for (int ct = 0; ct < 2; ++ct)
#pragma unroll
            for (int e = 0; e < 8; ++e) wn[ct][e] = w[(long)e * 6144 + 32 * ct];
        asm volatile("s_waitcnt lgkmcnt(0)" ::: "memory");
#pragma unroll 1
        for (int ks = 0; ks < 8; ++ks) {
            bf16x8 bfr[2];
#pragma unroll
            for (int ct = 0; ct < 2; ++ct) { const u32x4 bw = (u32x4){cvtpk(wn[ct][0], wn[ct][1]), cvtpk(wn[ct][2], wn[ct][3]), cvtpk(wn[ct][4], wn[ct][5]), cvtpk(wn[ct][6], wn[ct][7])}; bfr[ct] = __builtin_bit_cast(bf16x8, bw); }
            if (ks + 1 < 8) {
#pragma unroll
                for (int ct = 0; ct < 2; ++ct)
#pragma unroll
                    for (int e = 0; e < 8; ++e) wn[ct][e] = w[(long)(16 * (ks + 1) + e) * 6144 + 32 * ct]; }
#pragma unroll
            for (int rt = 0; rt < 2; ++rt) { const bf16x8 af = *(const LAS bf16x8*)(sl + (32 * rt + r32) * 256 + (16 * ks + 8 * hi) * 2);
#pragma unroll
                for (int ct = 0; ct < 2; ++ct) acc[rt][ct] = __builtin_amdgcn_mfma_f32_32x32x16_bf16(af, bfr[ct], acc[rt][ct], 0, 0, 0); }
        }
        __syncthreads();
        LAS float* part = (LAS float*)lds;
#pragma unroll
        for (int rt = 0; rt < 2; ++rt)
#pragma unroll
            for (int ct = 0; ct < 2; ++ct)
#pragma unroll
                for (int r = 0; r < 16; ++r) { const int row = 32 * rt + crow(r, hi); if (row < NMODROW) part[(wave * NMODROW + row) * 64 + 32 * ct + r32] = acc[rt][ct][r]; }
        __syncthreads();
        for (int o = threadIdx.x; o < NMODROW * 64; o += NTHR_) { float sum = p.in[I_ADAB][l * 6144 + j0 + (o & 63)];
#pragma unroll
            for (int w8 = 0; w8 < 8; ++w8) sum += part[w8 * NMODROW * 64 + o];
            wsp<float>(p, WS_MOD)[((long)l * NMODROW + (o >> 6)) * 6144 + j0 + (o & 63)] = sum; }
        __syncthreads();
    }
}

#define XB_TMO      128
#define XB_XCNT(j)  (256  + 64 * (j))
#define XB_XSUB(j)  (1280 + 64 * (j))
#define XB_XGEN(j)  (2304 + 64 * (j))
#define XB_TOP      3328
#define XB_TOPGEN   3392
#define XCD_BAR_WORDS 3456
#define XB_SPIN_CAP (1u << 22)
__device__ __forceinline__ unsigned xb_ld(unsigned* p)              { return __hip_atomic_load(p, __ATOMIC_RELAXED, __HIP_MEMORY_SCOPE_AGENT); }
__device__ __forceinline__ unsigned xb_add(unsigned* p, unsigned v) { return __hip_atomic_fetch_add(p, v, __ATOMIC_RELAXED, __HIP_MEMORY_SCOPE_AGENT); }
__device__ __forceinline__ unsigned xb_xcc_id() { return (unsigned)__builtin_amdgcn_s_getreg((3 << 11) | 20) & 0xFu; }
#define XB_SPIN(cond, bar) do { unsigned _sp = 0; while (cond) { __builtin_amdgcn_s_sleep(1); \
    if ((++_sp & 255u) == 0u) { if (xb_ld(&(bar)[XB_TMO])) break; if (_sp > XB_SPIN_CAP) { atomicAdd(&(bar)[XB_TMO], 1u); break; } } } } while (0)
struct XcdBarrier { unsigned* bar; unsigned x; volatile LAS unsigned* st; };
__device__ __forceinline__ XcdBarrier xcd_barrier_post(unsigned* bar, volatile LAS unsigned* st) {
    XcdBarrier b; b.bar = bar; b.x = xb_xcc_id(); b.st = st;
    if (threadIdx.x == 0) (void)xb_add(&bar[XB_XCNT(b.x)], 1u);
    return b;
}
__device__ __forceinline__ void xcd_barrier_complete(unsigned* bar, unsigned x, unsigned& nloc, unsigned& nx) {
    const unsigned G = gridDim.x * gridDim.y * gridDim.z;
    unsigned sum, cnt, mine, sp = 0u;
    for (;;) {
        sum = 0u; cnt = 0u; mine = 0u;
#pragma unroll
        for (unsigned j = 0; j < 16; ++j) { const unsigned c = xb_ld(&bar[XB_XCNT(j)]); sum += c; cnt += (c > 0u) ? 1u : 0u; mine = (j == x) ? c : mine; }
        if (sum == G) break;
        __builtin_amdgcn_s_sleep(1);
        if ((++sp & 255u) == 0u) { if (xb_ld(&bar[XB_TMO])) break; if (sp > XB_SPIN_CAP) { atomicAdd(&bar[XB_TMO], 1u); break; } }
    }
    nloc = mine > 0u ? mine : 1u; nx = cnt > 0u ? cnt : 1u;
}
__device__ __forceinline__ void xcd_barrier(const XcdBarrier& b) {
    asm volatile("s_waitcnt vmcnt(0)" ::: "memory");
    __syncthreads();
    if (threadIdx.x == 0) {
        unsigned* bar = b.bar;
        __builtin_amdgcn_s_waitcnt(0);
        unsigned nloc = b.st[0], nx = b.st[1];
        if (nloc == 0u) { xcd_barrier_complete(bar, b.x, nloc, nx); b.st[0] = nloc; b.st[1] = nx; }
        const unsigned old = xb_add(&bar[XB_XSUB(b.x)], 1u);
        const unsigned gen = old / nloc;
        if (old + 1u == (gen + 1u) * nloc) {
            __builtin_amdgcn_fence(__ATOMIC_RELEASE, "agent");
            asm volatile("s_waitcnt vmcnt(0)" ::: "memory");
            const unsigned og = xb_add(&bar[XB_TOP], 1u);
            const unsigned tg = og / nx;
            if (og + 1u == (tg + 1u) * nx) xb_add(&bar[XB_TOPGEN], 1u);
            else XB_SPIN(xb_ld(&bar[XB_TOPGEN]) == tg, bar);
            __builtin_amdgcn_fence(__ATOMIC_ACQUIRE, "agent");
            xb_add(&bar[XB_XGEN(b.x)], 1u);
            asm volatile("s_waitcnt vmcnt(0)" ::: "memory");
        } else {
            XB_SPIN(xb_ld(&bar[XB_XGEN(b.x)]) == gen, bar);
            __builtin_amdgcn_fence(__ATOMIC_ACQUIRE, "agent");
            asm volatile("s_waitcnt vmcnt(0)" ::: "memory");
        }
    }
    __syncthreads();
}


constexpr int NSU = 4 * DB * 2;
__device__ __forceinline__ int umod(int a, int G) { return __builtin_amdgcn_readfirstlane(G == 256 ? (a & 255) : a % G); }
__device__ __forceinline__ int tail_early(int nunits, int G) { const int ex = umod(nunits, G); return ex == 0 ? 0 : G - ex; }
constexpr int FFN_TAIL_CAP = 136;
__device__ __forceinline__ int early_from_ffn(int l, int G) { if (l == 0) return 0; const int e = tail_early((MP / 256) * (NFI / 256), G); return e < FFN_TAIL_CAP ? e : FFN_TAIL_CAP; }
__device__ __forceinline__ int early_total(int l, int G) { const int e = early_from_ffn(l, G) + tail_early((MP / 256) * (NINP / 256), G); return e < NSU ? e : NSU; }

constexpr int NWAVES = 8, NTHR = NWAVES * 64;
constexpr int RING_OFF = 0, RING_BYTES = 131072, LDSCTL_OFF = RING_BYTES, MISC_OFF = LDSCTL_OFF + 320, LDS_BYTES = 147456;
#ifndef MK_ONE_LAUNCH
#define MK_ONE_LAUNCH 1
#endif
struct Args { Params p; int ph_lo, ph_hi; };
static_assert(sizeof(Args) == sizeof(Params) + 8, "no padding in Args");

#define LAUNDER_TID int _tid = threadIdx.x; asm volatile("" : "+v"(_tid))
#define RUNST(n_items, CALL) do { LAUNDER_TID; const long _n = (long)(n_items); for (long i = (long)blockIdx.x * NTHR + _tid; i < _n; i += (long)gridDim.x * NTHR) { CALL; } } while (0)
#define RUNSP(n_items, CALL) do { LAUNDER_TID; const long _n = (long)(n_items); \
    for (long c_ = (long)(_tid >> 6) * gridDim.x + blockIdx.x; c_ * 64 < _n; c_ += (long)gridDim.x * NWAVES) { const long i = c_ * 64 + (_tid & 63); if (i < _n) { CALL; } } } while (0)
#define RUNWV(n_rows, CALL) do { LAUNDER_TID; const int lane_ = _tid & 63; const long _n = (long)(n_rows); \
    for (long i = __builtin_amdgcn_readfirstlane((_tid >> 6) * (int)gridDim.x + (int)blockIdx.x); i < _n; i += (long)gridDim.x * NWAVES) { CALL; } } while (0)
#ifndef PROBE_MASK
#define PROBE_MASK 0
#endif
#ifndef FUSE_NORM
#define FUSE_NORM 0
#endif
#define REPS_CAT2(a, b) a##b
#define REPS_CAT(a, b) REPS_CAT2(a, b)
#define REPS(bit) for (int REPS_CAT(rep_, bit) = 0; REPS_CAT(rep_, bit) < (((PROBE_MASK) >> (bit)) & 1 ? 2 : 1); ++REPS_CAT(rep_, bit))
#define PHASE_PARAMS Params q = args.p; { long z_ = 0; asm volatile("" : "+s"(z_)); q.ws += z_; q.out += z_; }

__global__ void __launch_bounds__(NTHR, 2) mk_fwd(Args args) {
    extern __shared__ __attribute__((aligned(16))) unsigned char lds[];
    const Params& p = args.p;
    LAS unsigned char* ldsl = (LAS unsigned char*)lds;
    volatile LAS unsigned* MISC = (volatile LAS unsigned*)(ldsl + MISC_OFF);
    const int tid = threadIdx.x;
    for (int u = tid; u < (LDS_BYTES - LDSCTL_OFF) / 4; u += NTHR) ((LAS unsigned*)(ldsl + LDSCTL_OFF))[u] = 0u;
    __syncthreads();
    unsigned* ctl = (unsigned*)(p.ws + WS_CTL);
    XcdBarrier bar; bar.bar = ctl + 4096; bar.x = 0; bar.st = nullptr;
    if (MK_ONE_LAUNCH) bar = xcd_barrier_post(ctl + 4096, MISC + 8);
    const int lo = args.ph_lo, hi = args.ph_hi;
#define IN(k) (lo <= (k) && (k) < hi)
#define SEAM(k) do { if (MK_ONE_LAUNCH && IN(k) && IN((k) + 1)) { xcd_barrier(bar); if ((PROBE_MASK >> 12) & 1) xcd_barrier(bar); } } while (0)
    const int G = gridDim.x, bx = blockIdx.x;
    if (IN(0)) { PHASE_PARAMS;
        REPS(2) {
        REPS(13) { LAUNDER_TID; fast_prologue_weights(q, ldsl, (int)((_tid >> 6) * gridDim.x + blockIdx.x), (int)gridDim.x * NWAVES, _tid >> 6, _tid & 63); __syncthreads(); }
        REPS(14) { LAUNDER_TID; fast_ada(q, ldsl, _tid >> 6, _tid & 63); }
        REPS(15) {
        { LAUNDER_TID; fast_cb(q, ldsl, _tid >> 6, _tid & 63); }
        RUNST((long)NROTPOS * 64, st_rot(q, i));
        }
        }
    }
    SEAM(0);
    for (int l = 0; l < DEPTH; ++l) {
        const int pb = 1 + PH_PER_LAYER * l;
        if (l == 0 || !FUSE_NORM) { if (IN(pb + 0)) { PHASE_PARAMS; REPS(7) { RUNWV((MP + NORM_NR - 1) / NORM_NR, fast_norm_rows<NORM_NR>(q, l, 0, (int)i, lane_)); if (FUSE_NORM) RUNWV(sk::SHP_TASKS, sk::shp_task(q, (int)i, lane_)); } }
        SEAM(pb + 0); }
        if (IN(pb + 1)) { PHASE_PARAMS; REPS(0) { pg8::Gemm g{wsp<bf16>(q, WS_XN), wsp<bf16>(q, WS_WTIN) + (size_t)l * NINP * DM, MP, NINP, DM}; pg8::StaticOrder S; S.init(MP, NINP, G, bx);
            EpiInProj E{q, l, (FUSE_NORM && l > 0) ? 1 : 0}; pg8::gemm_phase<EpiInProj, pg8::StaticOrder, true, true>(ldsl + RING_OFF, g, S, E);  }
            { const int ex = umod((MP / 256) * (NINP / 256), G); const int k = early_from_ffn(l, G) + (bx - ex); if (ex != 0 && bx >= ex && k < early_total(l, G)) cp::cmp_unit(q, l, 2 * NB + k, ldsl + RING_OFF); } }
        SEAM(pb + 1);
        if (IN(pb + 2)) { PHASE_PARAMS; REPS(3) { const int first = early_total(l, G), R = 2 * NB + (NSU - first);
            for (int it = bx; it < R; it += G) cp::cmp_unit(q, l, it < 2 * NB ? it : 2 * NB + first + (it - 2 * NB), ldsl + RING_OFF);
            { const int nbusy = R < G ? R : G, nidle = G - nbusy, NU = NB * RH * NCH;
              const bool allidle = nidle >= 64; const int u0 = allidle ? (bx < nbusy ? NU : bx - nbusy) : bx, us = nidle == 0 ? G : (bx < nbusy ? NU : nidle);
              for (int u = u0; u < NU; u += us) rt::retU_unit(q, u, ldsl + RING_OFF);
              if (l == DEPTH - 1) { LAUNDER_TID; const int cb0 = nidle >= 64 ? nbusy : 0, cnb = nidle >= 64 ? nidle : G;
                  if (bx >= cb0) for (long i = (long)(bx - cb0) * NTHR + _tid; i < 2L * DB * 508 * 256 / 16; i += (long)cnb * NTHR) fast_copywin(q, i); } } } }
        SEAM(pb + 2);
        if (IN(pb + 3)) { PHASE_PARAMS; REPS(6) { { LAUNDER_TID; cp::cmp_fin_mfma(q, l, __builtin_amdgcn_readfirstlane((_tid >> 6) * (int)gridDim.x + (int)blockIdx.x), (int)gridDim.x * NWAVES, _tid & 63, __builtin_amdgcn_readfirstlane(_tid >> 6), ldsl + RING_OFF); } RUNST((long)NB * RH * RDK * (RDV / 8), fast_retS8(q, l, i)); } }
        SEAM(pb + 3);
        if (IN(pb + 4)) { PHASE_PARAMS; REPS(1) { REPS(9) { fa::attn_prompt_phase(q, ldsl + RING_OFF); }
            const bool alg = (G == NB * 32) && (DB * 2 == NB * 8); const int vcu_ = (bx % 8) * (G / 8) + bx / 8, s_ = vcu_ % 16, bg_ = vcu_ / 16;
            const int su0 = alg ? (s_ < 4 ? bg_ * 4 + s_ : DB * 2) : bx, sus = alg ? DB * 2 : G;
            REPS(10) { for (int u = su0; u < DB * 2; u += sus) sa::attn_sample_unit(q, l, u >> 1, u & 1, ldsl + RING_OFF); }
            { const int G2 = alg ? G - DB * 2 : (G > 2 * DB * 2 ? G - DB * 2 : G), b2 = alg ? (s_ < 4 ? -1 : bg_ * 12 + (s_ - 4)) : (G > 2 * DB * 2 ? bx - DB * 2 : bx);
              REPS(11) { if (b2 >= 0 && b2 < NB * RH * NCH) { u32x4 pq[4], ps[8]; { LAUNDER_TID; rt::retO_fetch(q, b2, _tid, pq, ps); }
                  for (int u = b2; u < NB * RH * NCH; u += G2) { const int un = u + G2 < NB * RH * NCH ? u + G2 : -1; rt::retO_unit(q, l, u, un, pq, ps, ldsl + RING_OFF); } } } }
            retOs_block(q, l, ldsl + RING_OFF); RUNST(RETSS_Q, fast_retSs4x4(q, l, i)); } }
        SEAM(pb + 4);
        if (IN(pb + 9)) { PHASE_PARAMS; REPS(5) { { pg8::Gemm g{wsp<bf16>(q, WS_OA), wsp<bf16>(q, WS_WTOA) + (size_t)l * DM * 512, BT, DM, 512}; pg8::StaticOrder S; S.init(BT, DM, G, bx);
            EpiMixA E{q}; pg8::gemm_phase<EpiMixA, pg8::StaticOrder, true, true>(ldsl + RING_OFF, g, S, E); }
            { pg8::Gemm g{wsp<bf16>(q, WS_RO), wsp<bf16>(q, WS_WTOB) + (size_t)l * DM * DM, BT, DM, DM}; pg8::StaticOrder S; S.init(BT, DM, G, bx);
            EpiMixB E{q}; pg8::gemm_phase<EpiMixB, pg8::StaticOrder, true, true>(ldsl + RING_OFF, g, S, E); } }
            for (int t = blockIdx.x; t < sk::NT; t += gridDim.x) sk::mix_tile(q, l, t, ldsl + RING_OFF); }
        SEAM(pb + 9);
        if (IN(pb + 11)) { PHASE_PARAMS; pg8::Gemm g{wsp<bf16>(q, WS_MIX), wsp<bf16>(q, WS_WTO) + (size_t)l * DM * DM, BT, DM, DM}; pg8::StaticOrder S; S.init(BT, DM, G, bx);
            EpiResid E{q, l, 2048, FUSE_NORM ? 0 : -1, l == 0 ? 1 : 0}; pg8::gemm_phase<EpiResid, pg8::StaticOrder, true, true>(ldsl + RING_OFF, g, S, E);
            for (int t = blockIdx.x; t < sk::NT; t += gridDim.x) sk::resid_tile(q, l, wsp<bf16>(q, WS_MIX), wsp<bf16>(q, WS_WTO) + (size_t)l * DM * DM, DM, 2048, FUSE_NORM ? 0 : -1, l == 0 ? 1 : 0, t, ldsl + RING_OFF); }
        SEAM(pb + 11);
        if (!FUSE_NORM) { if (IN(pb + 12)) { PHASE_PARAMS; REPS(7) { RUNWV((MP + NORM_NR - 1) / NORM_NR, fast_norm_rows<NORM_NR>(q, l, 1, (int)i, lane_)); } }
        SEAM(pb + 12); }
        if (IN(pb + 13)) { PHASE_PARAMS; REPS(4) { pg8::Gemm g{wsp<bf16>(q, WS_XN), wsp<bf16>(q, WS_WTFI) + (size_t)l * NFI * DM, MP, NFI, DM}; pg8::StaticOrder S; S.init(MP, NFI, G, bx);
            EpiFfnIn E{q, l, FUSE_NORM}; pg8::gemm_phase<EpiFfnIn, pg8::StaticOrder, true, true>(ldsl + RING_OFF, g, S, E);  }
            if (l + 1 < DEPTH) { const int ex = umod((MP / 256) * (NFI / 256), G); const int k = bx - ex; if (ex != 0 && bx >= ex && k < early_from_ffn(l + 1, G)) cp::cmp_unit(q, l + 1, 2 * NB + k, ldsl + RING_OFF); } }
        SEAM(pb + 13);
        if (IN(pb + 14)) { PHASE_PARAMS; REPS(8) { RUNST(CONVFIX_N, fast_convfix(q, l, i));  } }
        SEAM(pb + 14);
        if (IN(pb + 15)) { PHASE_PARAMS; pg8::Gemm g{wsp<bf16>(q, WS_G), wsp<bf16>(q, WS_WTFO) + (size_t)l * DM * DFF, BT, DM, DFF}; pg8::StaticOrder S; S.init(BT, DM, G, bx);
            EpiResid E{q, l, 5120, (FUSE_NORM && l + 1 < DEPTH) ? 1 : -1}; pg8::gemm_phase<EpiResid, pg8::StaticOrder, true, true>(ldsl + RING_OFF, g, S, E);
            for (int t = blockIdx.x; t < sk::NT; t += gridDim.x) sk::resid_tile(q, l, wsp<bf16>(q, WS_G), wsp<bf16>(q, WS_WTFO) + (size_t)l * DM * DFF, DFF, 5120, (FUSE_NORM && l + 1 < DEPTH) ? 1 : -1, 0, t, ldsl + RING_OFF); }
        SEAM(pb + 15);
    }
    if (IN(N_PHASES - 1)) { PHASE_PARAMS; RUNWV((MREAL + NORM_NR - 1) / NORM_NR, fast_norm_rows<NORM_NR>(q, 0, 2, (int)i, lane_)); }
#undef IN
#undef SEAM
}

extern "C" void kernel_launch(void* const* d_in, const int* in_sizes, int n_in, void* d_out, int out_size, void* d_ws, size_t ws_size, hipStream_t stream) {
    static int grid = 0;
    if (grid == 0) {
        if (n_in != 27 || out_size != (int)O_END || ws_size < WS_END) { fprintf(stderr, "kernel_launch: unexpected sizes n_in %d out %d (want %ld) ws %zu (want %zu)\n", n_in, out_size, (long)O_END, ws_size, (size_t)WS_END); grid = -1; return; }
        int dev = 0, cus = 0, per_cu = 0;
        if (hipGetDevice(&dev) != hipSuccess || hipDeviceGetAttribute(&cus, hipDeviceAttributeMultiprocessorCount, dev) != hipSuccess) { grid = -1; return; }
        if (hipFuncSetAttribute((const void*)mk_fwd, hipFuncAttributeMaxDynamicSharedMemorySize, LDS_BYTES) != hipSuccess) { fprintf(stderr, "kernel_launch: hipFuncSetAttribute failed\n"); grid = -1; return; }
        if (hipOccupancyMaxActiveBlocksPerMultiprocessor(&per_cu, (const void*)mk_fwd, NTHR, LDS_BYTES) != hipSuccess || per_cu < 1) fprintf(stderr, "kernel_launch: occupancy query says %d\n", per_cu);
        (void)hipGetLastError();
        grid = cus;
    }
    if (grid < 0) return;
    (void)hipMemsetAsync((char*)d_ws + WS_CTL, 0, CTL_ZERO_BYTES, stream);
    Args a{};
    for (int i = 0; i < 27; ++i) a.p.in[i] = (const float*)d_in[i];
    a.p.out = (float*)d_out; a.p.ws = (unsigned char*)d_ws;
    if (MK_ONE_LAUNCH) { a.ph_lo = 0; a.ph_hi = N_PHASES; hipLaunchKernelGGL(mk_fwd, dim3(grid), dim3(NTHR), LDS_BYTES, stream, a); }
    else for (int ph = 0; ph < N_PHASES; ++ph) { a.ph_lo = ph; a.ph_hi = ph + 1; hipLaunchKernelGGL(mk_fwd, dim3(grid), dim3(NTHR), LDS_BYTES, stream, a); }
}
#endif
```

```cpp
#ifndef HOST_SIM
#include <hip/hip_runtime.h>
#define HD __host__ __device__ __forceinline__
#else
#define HD inline
#endif
#include <cstdio>
#include <cstdint>
#include <cmath>

#ifndef CFG_BATCH
#define CFG_BATCH 8
#endif
#ifndef CFG_DEC_BATCH
#define CFG_DEC_BATCH 32
#endif
constexpr int DM = 1024, NB = CFG_BATCH, T = 2048, DEPTH = 2, DB = CFG_DEC_BATCH, DS = 4, PAST = 8192, PAGE = 128;
constexpr int NPAGES = PAST / PAGE, USED = DB * NPAGES, NPHYS = USED + (USED / 4 > 1 ? USED / 4 : 1);
constexpr int NSELP = T / 64, NSELS = (PAST + DS + 63) / 64, NCMPP = T / 16 - 1, NCMPS = (PAST + DS) / 16 - 1;
constexpr int WIN = 512, RH = 4, RDK = 128, RDV = 256, RC = 128, NCH = T / RC, DFF = 2816;
constexpr int BT = NB * T, NS = DB * DS, MREAL = BT + NS, MP = ((MREAL + 255) / 256) * 256;
constexpr int N_IN = 6424, NINP = 6656, NFI = 2 * DFF;
constexpr int NMODROW = NB + DB;
constexpr float C2 = 0.125f * 1.4426950408889634f;
constexpr float NEGF = -1e30f;
constexpr int CMPROWS = NB * 128 + DB * 512;
constexpr int PCW = 512, IMPW = 160;

constexpr long O_YP = 0, O_YS = O_YP + (long)BT * DM, O_CMPP = O_YS + (long)NS * DM, O_CMPS = O_CMPP + 2L * BT * 256,
               O_SELP = O_CMPS + 2L * NS * 256, O_SELS = O_SELP + 2L * BT * 256, O_WINP = O_SELS + 2L * NS * 256,
               O_WINS = O_WINP + 2L * NB * 512 * 256, O_RETP = O_WINS + 2L * DB * 512 * 256, O_RETS = O_RETP + 2L * NB * RH * RDK * RDV,
               O_CONVP = O_RETS + 2L * DB * RH * RDK * RDV, O_CONVS = O_CONVP + 2L * NB * 2 * DFF, O_END = O_CONVS + 2L * DB * 2 * DFF;

typedef unsigned short bf16;
typedef float f32x4 __attribute__((ext_vector_type(4)));
typedef unsigned u32x4 __attribute__((ext_vector_type(4)));

constexpr size_t al256(size_t x) { return (x + 255) & ~(size_t)255; }
constexpr size_t WS_CTL = 0, CTL_ZERO_BYTES = 1u << 20;
constexpr size_t WS_WTIN = CTL_ZERO_BYTES;
constexpr size_t WS_WTOA = WS_WTIN + al256(2UL * NINP * DM * 2);
constexpr size_t WS_WTOB = WS_WTOA + al256(2UL * DM * 512 * 2);
constexpr size_t WS_WTO = WS_WTOB + al256(2UL * DM * DM * 2);
constexpr size_t WS_WTFI = WS_WTO + al256(2UL * DM * DM * 2);
constexpr size_t WS_WTFO = WS_WTFI + al256(2UL * NFI * DM * 2);
constexpr size_t WS_MOD = WS_WTFO + al256(2UL * DM * DFF * 2);
constexpr size_t WS_CB = WS_MOD + al256(2UL * NMODROW * 6144 * 4);
constexpr int NROTPOS = T + DS;
constexpr size_t WS_ROT = WS_CB + al256(2 * 2 * 64 * 4);
constexpr size_t WS_X = WS_ROT + al256((size_t)NROTPOS * 64 * 2 * 4);
constexpr size_t WS_XN = WS_X + al256((size_t)MP * DM * 4);
constexpr size_t WS_QB = WS_XN + al256((size_t)MP * DM * 2);
constexpr size_t WS_KVS = WS_QB + al256((size_t)MP * 512 * 2);
constexpr size_t WS_KVW = WS_KVS + al256((size_t)MP * 256 * 2);
constexpr size_t WS_RQ = WS_KVW + al256((size_t)MP * 256 * 2);
constexpr size_t WS_RK = WS_RQ + al256((size_t)MP * 512 * 2);
constexpr size_t WS_RV = WS_RK + al256((size_t)MP * 512 * 2);
constexpr size_t WS_SRG = WS_RV + al256((size_t)MP * DM * 2);
constexpr size_t WS_SGA = WS_SRG + al256((size_t)MP * DM * 2);
constexpr size_t WS_SGB = WS_SGA + al256((size_t)MP * DM * 2);
constexpr size_t WS_AG = WS_SGB + al256((size_t)MP * DM * 2);
constexpr size_t WS_HID = WS_AG + al256((size_t)MP * 32 * 4);
constexpr size_t WS_KC = WS_HID + al256((size_t)CMPROWS * 256 * 4);
constexpr size_t WS_PC = WS_KC + al256((size_t)CMPROWS * 256 * 2);
constexpr size_t WS_IMP = WS_PC + al256((size_t)MP * 8 * PCW * 4);
constexpr size_t WS_SELB = WS_IMP + al256((size_t)MP * 2 * IMPW * 4);
constexpr size_t WS_OC = WS_SELB + al256((size_t)MP * 2 * IMPW);
constexpr size_t WS_OA = WS_OC + al256((size_t)MP * 512 * 4);
constexpr size_t WS_RETU = WS_OA + al256((size_t)MP * 512 * 2);
constexpr size_t WS_RETS = WS_RETU + al256((size_t)NB * RH * NCH * RDK * RDV * 2);
constexpr size_t WS_INNER = WS_RETS + al256((size_t)NB * RH * NCH * RDK * RDV * 2);
constexpr size_t WS_ORAW = WS_INNER + al256((size_t)NB * RH * NCH * RC * RC * 4);
constexpr size_t WS_RO = WS_ORAW + al256((size_t)MP * DM * 4);
constexpr size_t WS_MIXT = WS_RO + al256((size_t)MP * DM * 2);
constexpr size_t WS_MIX = WS_MIXT + al256((size_t)MP * DM * 4);
constexpr size_t WS_FA = WS_MIX + al256((size_t)MP * DM * 2);
constexpr size_t WS_FB = WS_FA + al256((size_t)MP * DFF * 2);
constexpr size_t WS_G = WS_FB + al256((size_t)MP * DFF * 2);
constexpr size_t WS_W1T = WS_G + al256((size_t)MP * DFF * 2);
constexpr size_t WS_PCMP = WS_W1T + al256(2UL * 2 * 128 * 1024 * 2);
constexpr size_t WS_SHP = WS_PCMP + al256((size_t)CMPROWS * 512 * 4);
constexpr size_t WS_SSP = WS_SHP + al256(3UL * 64 * NINP * 4);
constexpr size_t WS_END = WS_SSP + al256((size_t)MP * 32 * 4);

struct Params {
    const float* in[27];
    float* out;
    unsigned char* ws;
};
enum { I_XP = 0, I_XS, I_CP, I_CS, I_CCMP, I_CSEL, I_SWIN, I_SRET, I_SCONV, I_PT, I_N1W, I_ADAW, I_ADAB, I_WIN, I_CPOS, I_CW1, I_CW2, I_WOA, I_GNW, I_WOB,
       I_WO, I_N2W, I_FWI, I_FCW, I_FCB, I_FWO, I_NFW };

HD unsigned f2bf(float f) { unsigned u = __builtin_bit_cast(unsigned, f); return (u + 0x7fffu + ((u >> 16) & 1u)) >> 16; }
HD float bf2f(bf16 b) { return __builtin_bit_cast(float, (unsigned)b << 16); }
#if defined(HOST_SIM)
HD unsigned pk2(float lo, float hi) { return f2bf(lo) | (f2bf(hi) << 16); }
#else
typedef float pk_f32x2 __attribute__((ext_vector_type(2))); typedef __bf16 pk_bf16x2 __attribute__((ext_vector_type(2)));
__host__ __device__ __forceinline__ unsigned pk2(float lo, float hi) {
#if defined(__HIP_DEVICE_COMPILE__)
    pk_f32x2 v = {lo, hi}; pk_bf16x2 b = __builtin_convertvector(v, pk_bf16x2); return __builtin_bit_cast(unsigned, b);
#else
    return f2bf(lo) | (f2bf(hi) << 16);
#endif
}
#endif
#if defined(HOST_SIM)
HD float sigmoidf_(float x) { return 1.f / (1.f + expf(-x)); }
HD float siluf_(float x) { return x / (1.f + expf(-x)); }
HD float geluf_(float x) { return 0.5f * x * (1.f + tanhf(0.7978845608028654f * (x + 0.044715f * x * x * x))); }
#else
__device__ __forceinline__ float sigmoidf_(float x) { return __builtin_amdgcn_rcpf(1.f + __builtin_amdgcn_exp2f(-1.4426950408889634f * x)); }
__device__ __forceinline__ float siluf_(float x) { return x * sigmoidf_(x); }
__device__ __forceinline__ float geluf_(float x) { return x * __builtin_amdgcn_rcpf(1.f + __builtin_amdgcn_exp2f(-2.302208198f * (x + 0.044715f * x * x * x))); }
#endif
HD float retlg(int h) { return logf(1.f - exp2f(-5.f - (float)h)); }
template <class Tp> HD Tp* wsp(const Params& p, size_t off) { return (Tp*)(p.ws + off); }
struct RowInfo { int kind, b, t, modrow, pos; };
HD RowInfo rowinfo(int m) { RowInfo r; if (m < BT) { r.kind = 0; r.b = m / T; r.t = m % T; r.modrow = r.b; r.pos = r.t; }
    else if (m < MREAL) { r.kind = 1; r.b = (m - BT) / DS; r.t = (m - BT) % DS; r.modrow = NB + r.b; r.pos = PAST + r.t; }
    else { r.kind = 2; r.b = 0; r.t = 0; r.modrow = 0; r.pos = 0; } return r; }

HD int win_srccol(int n) {
    if (n < 1280) return n;
    if (n < 2304) { const int q = n - 1280, seg = q / 512, r = q % 512, head = r / 128, pp = r % 128, j = pp % 8, i0 = 4 * (pp / 8);
        const int d = j < 4 ? i0 + j : 64 + i0 + (j - 4); return 1304 + seg * 512 + head * 128 + d; }
    if (n < 6400) return n + 24;
    if (n < 6424) return 1280 + (n - 6400);
    return -1;
}
HD void st_wt_in(const Params& p, long i) { const int l = (int)(i / ((long)NINP * DM)); const long r = i % ((long)NINP * DM); const int n = (int)(r / DM), k = (int)(r % DM);
    const int sc = win_srccol(n); wsp<bf16>(p, WS_WTIN)[i] = sc < 0 ? (bf16)0 : (bf16)f2bf(p.in[I_WIN][((long)l * DM + k) * N_IN + sc]); }
HD void st_wt_fi(const Params& p, long i) { const int l = (int)(i / ((long)NFI * DM)); const long r = i % ((long)NFI * DM); const int n = (int)(r / DM), k = (int)(r % DM);
    const int pn = n / 256, bj = (n % 256) / 128, q = n % 128; const int sc = bj * DFF + pn * 128 + q;
    wsp<bf16>(p, WS_WTFI)[i] = (bf16)f2bf(p.in[I_FWI][((long)l * DM + k) * NFI + sc]); }
HD void st_wt_plain(const float* W, bf16* WT, int K, int N, long i) {
    const int l = (int)(i / ((long)N * K)); const long r = i % ((long)N * K); const int n = (int)(r / K), k = (int)(r % K);
    WT[i] = (bf16)f2bf(W[((long)l * K + k) * N + n]); }
HD void st_ada(const Params& p, long i) { const int l = (int)(i / ((long)NMODROW * 6144)); const long r = i % ((long)NMODROW * 6144); const int row = (int)(r / 6144), j = (int)(r % 6144);
    const float* c = row < NB ? p.in[I_CP] + (long)row * DM : p.in[I_CS] + (long)(row - NB) * DM;
    const float* w = p.in[I_ADAW] + (long)l * DM * 6144 + j; float acc = p.in[I_ADAB][l * 6144 + j];
    for (int k = 0; k < DM; ++k) acc += siluf_(c[k]) * w[(long)k * 6144];
    wsp<float>(p, WS_MOD)[i] = acc; }
HD void st_cb(const Params& p, long i) { const int l = (int)(i / 128), e = (int)(i / 64) % 2, h = (int)(i % 64);
    const float* pos = p.in[I_CPOS] + ((long)l * 2 + e) * 2048; const float* w1 = p.in[I_CW1] + ((long)l * 2 + e) * 2048 * 64 + h; float acc = 0.f;
    for (int k = 0; k < 2048; ++k) acc += pos[k] * w1[(long)k * 64];
    wsp<float>(p, WS_CB)[i] = acc; }
HD void st_rot(const Params& p, long i) { const int pi = (int)(i / 64), k = (int)(i % 64); const double pos = pi < T ? (double)pi : (double)(PAST + pi - T);
    const double inv = exp(-9.210340371976184 * (double)k * (1.0 / 64.0)); const double ang = pos * inv; const double kk = rint(ang * 0.15915494309189535); const float r = (float)(ang - kk * 6.283185307179586);
    float* o = wsp<float>(p, WS_ROT) + i * 2; o[0] = cosf(r); o[1] = sinf(r); }
HD void st_copywin(const Params& p, long i) {
    const long per = 508L * 256; const int lb = (int)(i / per); const long r = i % per;
    p.out[O_WINS + (long)lb * 512 * 256 + r] = p.in[I_SWIN][(long)lb * 512 * 256 + 4 * 256 + r]; }
HD void st_norm(const Params& p, int l, int which, long m) {
    const RowInfo ri = rowinfo((int)m); bf16* xn = wsp<bf16>(p, WS_XN) + m * DM; float* X = wsp<float>(p, WS_X) + m * DM;
    if (ri.kind == 2) { if (which != 2) for (int k = 0; k < DM; ++k) xn[k] = 0; return; }
    const float* src = X;
    if (which == 0 && l == 0) src = ri.kind == 0 ? p.in[I_XP] + m * DM : p.in[I_XS] + (m - BT) * DM;
    float ss = 0.f; for (int k = 0; k < DM; ++k) { const float v = src[k]; ss += v * v; }
    const float rs = 1.f / sqrtf(ss * (1.f / DM) + 1e-6f);
    if (which == 2) { float* y = ri.kind == 0 ? p.out + O_YP + m * DM : p.out + O_YS + (m - BT) * DM; const float* w = p.in[I_NFW];
        for (int k = 0; k < DM; ++k) y[k] = src[k] * rs * w[k]; return; }
    const float* w = (which == 0 ? p.in[I_N1W] : p.in[I_N2W]) + l * DM; const float* mod = wsp<float>(p, WS_MOD) + ((long)l * NMODROW + ri.modrow) * 6144 + (which == 0 ? 0 : 3072);
    for (int k = 0; k < DM; ++k) { const float v = src[k]; xn[k] = (bf16)f2bf(v * rs * w[k] * (1.f + mod[1024 + k]) + mod[k]); if (which == 0 && l == 0) X[k] = v; }
}
HD const float* cmp_src_tok(const Params& p, int l, int crow, int tok) {
    if (crow < NB * 128) { const int b = crow / 128; return p.out + O_CMPP + (((long)l * NB + b) * T + tok) * 256; }
    const int b = (crow - NB * 128) / 512; const int pg = ((const int*)p.in[I_PT])[b * NPAGES + tok / PAGE];
    return p.in[I_CCMP] + (((long)l * NPHYS + pg) * PAGE + tok % PAGE) * 256; }
HD bool cmp_row_valid(int crow, int& n) { if (crow < NB * 128) { n = crow % 128; return n < NCMPP; } n = (crow - NB * 128) % 512; return n < NCMPS; }
HD void st_hid(const Params& p, int l, long i) { const int crow = (int)(i / 256), rem = (int)(i % 256), e = rem / 128, g = (rem / 64) % 2, h = rem % 64; int n;
    float* dst = wsp<float>(p, WS_HID) + i; if (!cmp_row_valid(crow, n)) { *dst = 0.f; return; }
    float acc = wsp<float>(p, WS_CB)[(l * 2 + e) * 64 + h]; const float* w1 = p.in[I_CW1] + ((long)l * 2 + e) * 2048 * 64 + h;
    for (int lp = 0; lp < 32; ++lp) { const float* kv = cmp_src_tok(p, l, crow, 16 * n + lp) + e * 128 + g * 64;
        for (int d = 0; d < 64; ++d) acc += kv[d] * w1[(long)(lp * 64 + d) * 64]; }
    *dst = geluf_(acc); }
HD void st_kc(const Params& p, int l, long i) { const int crow = (int)(i / 256), rem = (int)(i % 256), e = rem / 128, g = (rem / 64) % 2, d = rem % 64;
    const float* hid = wsp<float>(p, WS_HID) + (long)crow * 256 + e * 128 + g * 64; const float* w2 = p.in[I_CW2] + ((long)l * 2 + e) * 64 * 64 + d; float acc = 0.f;
    for (int h = 0; h < 64; ++h) acc += hid[h] * w2[h * 64];
    wsp<bf16>(p, WS_KC)[i] = (bf16)f2bf(acc); }
HD void st_cmpattn(const Params& p, int l, long i) { const int m = (int)(i / 8), hq = (int)(i % 8), g = hq / 4; const RowInfo ri = rowinfo(m);
    const int kcb = ri.kind == 0 ? ri.b * 128 : NB * 128 + ri.b * 512, ncmp = ri.kind == 0 ? NCMPP : NCMPS;
    int nv = ri.pos >= 31 ? (ri.pos - 31) / 16 + 1 : 0; if (nv > ncmp) nv = ncmp;
    float q[64]; const bf16* qb = wsp<bf16>(p, WS_QB) + (long)m * 512 + hq * 64;
#pragma unroll
    for (int d = 0; d < 64; ++d) q[d] = bf2f(qb[d]);
    float* pc = wsp<float>(p, WS_PC) + ((long)m * 8 + hq) * PCW; const bf16* kc = wsp<bf16>(p, WS_KC) + (long)kcb * 256 + g * 64;
    float mx = NEGF;
    for (int n = 0; n < nv; ++n) { const bf16* k = kc + (long)n * 256; float s = 0.f;
#pragma unroll
        for (int d = 0; d < 64; ++d) s += q[d] * bf2f(k[d]);
        pc[n] = s; mx = fmaxf(mx, s); }
    float o[64];
#pragma unroll
    for (int d = 0; d < 64; ++d) o[d] = 0.f;
    float lsum = 0.f;
    for (int n = 0; n < nv; ++n) { const float pr = exp2f(pc[n] - mx); pc[n] = pr; lsum += pr; const bf16* v = kc + (long)n * 256 + 128;
#pragma unroll
        for (int d = 0; d < 64; ++d) o[d] += pr * bf2f(v[d]); }
    const float il = nv > 0 ? 1.f / lsum : 0.f;
    for (int n = 0; n < nv; ++n) pc[n] *= il;
    for (int n = nv; n < ncmp + 1; ++n) pc[n] = 0.f;
    float* oc = wsp<float>(p, WS_OC) + (long)m * 512 + hq * 64;
#pragma unroll
    for (int d = 0; d < 64; ++d) oc[d] = o[d] * il; }
HD void st_imp(const Params& p, int l, long i) { const int m = (int)(i / (2 * IMPW)), g = (int)(i / IMPW) % 2, j = (int)(i % IMPW); const RowInfo ri = rowinfo(m);
    const int nsel = ri.kind == 0 ? NSELP : NSELS, ncmp = ri.kind == 0 ? NCMPP : NCMPS; float* dst = wsp<float>(p, WS_IMP) + i;
    if (j >= nsel) { *dst = NEGF; return; }
    float imp = 0.f;
    for (int hq = 0; hq < 4; ++hq) { const float* pc = wsp<float>(p, WS_PC) + ((long)m * 8 + g * 4 + hq) * PCW;
        for (int n = 4 * j - 1; n <= 4 * j + 3; ++n) if (n >= 0 && n < ncmp) imp += pc[n]; }
    const int cur = ri.pos / 64; const bool ok = j * 64 <= ri.pos, forced = (j == 0) || (j == cur) || (j == cur - 1);
    *dst = ok ? imp + (forced ? 1e4f : 0.f) : NEGF; }
HD void st_topk(const Params& p, int l, long i) { const int m = (int)(i / (2 * IMPW)), g = (int)(i / IMPW) % 2, j = (int)(i % IMPW); const RowInfo ri = rowinfo(m);
    const int nsel = ri.kind == 0 ? NSELP : NSELS; unsigned char* dst = wsp<unsigned char>(p, WS_SELB) + i;
    if (j >= nsel) { *dst = 0; return; }
    const float* sc = wsp<float>(p, WS_IMP) + ((long)m * 2 + g) * IMPW; const float s = sc[j]; int rank = 0;
    for (int jj = 0; jj < nsel; ++jj) { const float t = sc[jj]; rank += (t > s || (t == s && jj < j)) ? 1 : 0; }
    *dst = (rank < 16 && s > 0.5f * NEGF) ? 1 : 0; }
HD float rbf(float x) { return bf2f((bf16)f2bf(x)); }
HD void st_selwin(const Params& p, int l, long i) { const int m = (int)(i / 8), hq = (int)(i % 8), g = hq / 4; const RowInfo ri = rowinfo(m);
    float q[64]; const bf16* qb = wsp<bf16>(p, WS_QB) + (long)m * 512 + hq * 64;
#pragma unroll
    for (int d = 0; d < 64; ++d) q[d] = bf2f(qb[d]);
    const float* ag = wsp<float>(p, WS_AG) + (long)m * 32 + hq * 3; float* oc = wsp<float>(p, WS_OC) + (long)m * 512 + hq * 64;
    const unsigned char* selb = wsp<unsigned char>(p, WS_SELB) + ((long)m * 2 + g) * IMPW; const int nsel = ri.kind == 0 ? NSELP : NSELS;
    for (int br = 1; br < 3; ++br) {
        float o[64], mx = NEGF, lsum = 0.f;
#pragma unroll
        for (int d = 0; d < 64; ++d) o[d] = 0.f;
        int tlo = 0; const int thi = ri.pos; if (br == 2) { tlo = ri.pos - (WIN - 1); if (tlo < 0) tlo = 0; }
        for (int tok = tlo; tok <= thi; ++tok) {
            if (br == 1) { const int j = tok / 64; if (j >= nsel || !selb[j]) { tok = j * 64 + 63; continue; } }
            const bf16* sb = nullptr; const float* sf = nullptr;
            if (ri.kind == 0 || tok >= PAST) { const long row = ri.kind == 0 ? (long)ri.b * T + tok : (long)BT + ri.b * DS + (tok - PAST); sb = wsp<bf16>(p, br == 1 ? WS_KVS : WS_KVW) + row * 256 + g * 64; }
            else if (br == 1) { const int pg = ((const int*)p.in[I_PT])[ri.b * NPAGES + tok / PAGE]; sf = p.in[I_CSEL] + (((long)l * NPHYS + pg) * PAGE + tok % PAGE) * 256 + g * 64; }
            else sf = p.in[I_SWIN] + (((long)l * DB + ri.b) * 512 + (tok - (PAST - 512))) * 256 + g * 64;
            float s = 0.f;
            if (sb) {
#pragma unroll
                for (int d = 0; d < 64; ++d) s += q[d] * bf2f(sb[d]); }
            else {
#pragma unroll
                for (int d = 0; d < 64; ++d) s += q[d] * rbf(sf[d]); }
            if (s > mx) { const float f = exp2f(mx - s); lsum *= f;
#pragma unroll
                for (int d = 0; d < 64; ++d) o[d] *= f;
                mx = s; }
            const float pr = exp2f(s - mx); lsum += pr;
            if (sb) {
#pragma unroll
                for (int d = 0; d < 64; ++d) o[d] += pr * bf2f(sb[128 + d]); }
            else {
#pragma unroll
                for (int d = 0; d < 64; ++d) o[d] += pr * rbf(sf[128 + d]); } }
        const float gl = ag[br] / lsum;
        if (br == 1) {
#pragma unroll
            for (int d = 0; d < 64; ++d) oc[d] = ag[0] * oc[d] + gl * o[d]; }
        else { bf16* oa = wsp<bf16>(p, WS_OA) + (long)m * 512 + hq * 64;
#pragma unroll
            for (int d = 0; d < 64; ++d) oa[d] = (bf16)f2bf(oc[d] + gl * o[d]); } } }
HD void st_retU(const Params& p, long i) { const int j = (int)(i % RDV), ii = (int)(i / RDV) % RDK, n = (int)(i / (RDV * RDK)) % NCH, h = (int)(i / ((long)RDV * RDK * NCH)) % RH, b = (int)(i / ((long)RDV * RDK * NCH * RH));
    const float lg = retlg(h); const bf16* rk = wsp<bf16>(p, WS_RK) + ((long)b * T + n * RC) * 512 + h * RDK + ii; const bf16* rv = wsp<bf16>(p, WS_RV) + ((long)b * T + n * RC) * DM + h * RDV + j; float acc = 0.f;
    for (int c = 0; c < RC; ++c) acc += bf2f(rk[(long)c * 512]) * expf((float)(RC - 1 - c) * lg) * bf2f(rv[(long)c * DM]);
    wsp<bf16>(p, WS_RETU)[i] = (bf16)f2bf(acc); }
HD void st_retS(const Params& p, int l, long i) { const int j = (int)(i % RDV), ii = (int)(i / RDV) % RDK, h = (int)(i / (RDV * RDK)) % RH, b = (int)(i / (RDV * RDK * RH));
    const float sdec = expf((float)RC * retlg(h)); float S = 0.f;
    for (int n = 0; n < NCH; ++n) { const long idx = ((((long)b * RH + h) * NCH + n) * RDK + ii) * RDV + j; wsp<bf16>(p, WS_RETS)[idx] = (bf16)f2bf(S); S = S * sdec + bf2f(wsp<bf16>(p, WS_RETU)[idx]); }
    p.out[O_RETP + ((((long)l * NB + b) * RH + h) * RDK + ii) * RDV + j] = S; }
HD void st_inner(const Params& p, long i) { const int e = (int)(i % RC), c = (int)(i / RC) % RC, n = (int)(i / (RC * RC)) % NCH, h = (int)(i / (RC * RC * NCH)) % RH, b = (int)(i / (RC * RC * NCH * RH));
    float* dst = wsp<float>(p, WS_INNER) + i; if (e > c) { *dst = 0.f; return; }
    const bf16* q = wsp<bf16>(p, WS_RQ) + ((long)b * T + n * RC + c) * 512 + h * RDK; const bf16* k = wsp<bf16>(p, WS_RK) + ((long)b * T + n * RC + e) * 512 + h * RDK; float acc = 0.f;
    for (int d = 0; d < RDK; ++d) acc += bf2f(q[d]) * bf2f(k[d]);
    *dst = acc * expf((float)(c - e) * retlg(h)); }
HD void st_retO(const Params& p, long i) { const int j = (int)(i % RDV), h = (int)(i / RDV) % RH; const long m = i / (RDV * RH); const int b = (int)(m / T), t = (int)(m % T), n = t / RC, c = t % RC;
    const float* inner = wsp<float>(p, WS_INNER) + ((((long)b * RH + h) * NCH + n) * RC + c) * RC; const bf16* rv = wsp<bf16>(p, WS_RV) + ((long)b * T + n * RC) * DM + h * RDV + j; float acc = 0.f;
    for (int e = 0; e <= c; ++e) acc += inner[e] * bf2f(rv[(long)e * DM]);
    const bf16* q = wsp<bf16>(p, WS_RQ) + m * 512 + h * RDK; const bf16* S = wsp<bf16>(p, WS_RETS) + ((((long)b * RH + h) * NCH + n) * RDK) * RDV + j; float acc2 = 0.f;
    for (int d = 0; d < RDK; ++d) acc2 += bf2f(q[d]) * bf2f(S[(long)d * RDV]);
    wsp<float>(p, WS_ORAW)[m * DM + h * RDV + j] = acc + acc2 * expf((float)(c + 1) * retlg(h)); }
HD void st_retOs(const Params& p, int l, long i) { const int j = (int)(i % RDV), h = (int)(i / RDV) % RH; const int sr = (int)(i / (RDV * RH)), b = sr / DS, t = sr % DS; const long m = BT + sr; const float lg = retlg(h);
    const bf16* q = wsp<bf16>(p, WS_RQ) + m * 512 + h * RDK; float acc = 0.f;
    for (int e = 0; e <= t; ++e) { const long me = BT + b * DS + e; const bf16* k = wsp<bf16>(p, WS_RK) + me * 512 + h * RDK; float s = 0.f;
        for (int d = 0; d < RDK; ++d) s += bf2f(q[d]) * bf2f(k[d]);
        acc += s * expf((float)(t - e) * lg) * bf2f(wsp<bf16>(p, WS_RV)[me * DM + h * RDV + j]); }
    const float* S0 = p.in[I_SRET] + ((((long)l * DB + b) * RH + h) * RDK) * RDV + j; float acc2 = 0.f;
    for (int d = 0; d < RDK; ++d) acc2 += bf2f(q[d]) * S0[(long)d * RDV];
    wsp<float>(p, WS_ORAW)[m * DM + h * RDV + j] = acc + acc2 * expf((float)(t + 1) * lg); }
HD void st_retSs(const Params& p, int l, long i) { const int j = (int)(i % RDV), ii = (int)(i / RDV) % RDK, h = (int)(i / (RDV * RDK)) % RH, b = (int)(i / (RDV * RDK * RH)); const float lg = retlg(h);
    const long idx = ((((long)l * DB + b) * RH + h) * RDK + ii) * RDV + j; float S = p.in[I_SRET][idx] * expf((float)DS * lg);
    for (int c = 0; c < DS; ++c) { const long mc = BT + b * DS + c; S += bf2f(wsp<bf16>(p, WS_RK)[mc * 512 + h * RDK + ii]) * expf((float)(DS - 1 - c) * lg) * bf2f(wsp<bf16>(p, WS_RV)[mc * DM + h * RDV + j]); }
    p.out[O_RETS + idx] = S; }
HD void st_gn(const Params& p, int l, long i) { const long m = i / RH; const int h = (int)(i % RH); const float* o = wsp<float>(p, WS_ORAW) + m * DM + h * RDV; float mu = 0.f;
    for (int j = 0; j < RDV; ++j) mu += o[j];
    mu *= (1.f / RDV); float var = 0.f;
    for (int j = 0; j < RDV; ++j) { const float d = o[j] - mu; var += d * d; }
    const float rs = 1.f / sqrtf(var * (1.f / RDV) + 1e-5f); const float* w = p.in[I_GNW] + l * DM + h * RDV; const bf16* srg = wsp<bf16>(p, WS_SRG) + m * DM + h * RDV; bf16* ro = wsp<bf16>(p, WS_RO) + m * DM + h * RDV;
    for (int j = 0; j < RDV; ++j) ro[j] = (bf16)f2bf(bf2f(srg[j]) * (o[j] - mu) * rs * w[j]); }
HD void st_conv(const Params& p, int l, long i) { const long m = i / DFF; const int col = (int)(i % DFF); const RowInfo ri = rowinfo((int)m);
    const bf16* fa = wsp<bf16>(p, WS_FA); const float* cw = p.in[I_FCW] + (long)l * 3 * DFF + col;
    const float* prev = ri.kind == 1 ? p.in[I_SCONV] + (((long)l * DB + ri.b) * 2) * DFF + col : nullptr;
    const float a0 = bf2f(fa[m * DFF + col]);
    const float a1 = ri.t >= 1 ? bf2f(fa[(m - 1) * DFF + col]) : (prev ? prev[DFF] : 0.f);
    const float a2 = ri.t >= 2 ? bf2f(fa[(m - 2) * DFF + col]) : (prev ? prev[ri.t * DFF] : 0.f);
    const float u = p.in[I_FCB][l * DFF + col] + a2 * cw[0] + a1 * cw[DFF] + a0 * cw[2 * DFF];
    wsp<bf16>(p, WS_G)[m * DFF + col] = (bf16)f2bf(geluf_(u) * bf2f(wsp<bf16>(p, WS_FB)[m * DFF + col])); }
HD void st_zero_pad(const Params& p, long i) { const long r = i / 4352, c = i % 4352; const long m = MREAL + r;
    if (c < 512) wsp<bf16>(p, WS_OA)[m * 512 + c] = 0; else if (c < 1536) wsp<bf16>(p, WS_RO)[m * DM + c - 512] = 0; else wsp<bf16>(p, WS_G)[m * DFF + c - 1536] = 0; }


HD const float* fuse_nw(const Params& p, int l, int kind) { return kind == 0 ? p.in[I_N2W] + l * DM : p.in[I_N1W] + (l + 1) * DM; }
HD const float* fuse_sc(const Params& p, int l, int kind, int modrow) { return kind == 0 ? wsp<float>(p, WS_MOD) + ((long)l * NMODROW + modrow) * 6144 + 4096 : wsp<float>(p, WS_MOD) + ((long)(l + 1) * NMODROW + modrow) * 6144 + 1024; }
#ifdef HOST_SIM
constexpr int SSP_PROMPT = 16, SSP_SAMPLE = 16;
#else
constexpr int SSP_PROMPT = 16, SSP_SAMPLE = 32;
#endif
HD float fuse_rs_fin(f32x4 a) { return 1.f / sqrtf(((a[0] + a[1]) + (a[2] + a[3])) * (1.f / DM) + 1e-6f); }
HD void fuse_rs8(const Params& p, int pm, int wr, int fr, float (&rsv)[2][4]) {
    const float* sp = wsp<float>(p, WS_SSP) + (long)(pm * 256 + wr * 64 + fr) * 32;
#ifndef HOST_SIM
    if (pm < BT / 256) {
#endif
        f32x4 a[2][4];
#pragma unroll
        for (int ai = 0; ai < 2; ++ai)
#pragma unroll
            for (int m = 0; m < 4; ++m) a[ai][m] = *(const f32x4*)(sp + (long)(ai * 128 + m * 16) * 32);
#pragma unroll
        for (int ai = 0; ai < 2; ++ai)
#pragma unroll
            for (int m = 0; m < 4; ++m) rsv[ai][m] = fuse_rs_fin(a[ai][m]);
#ifndef HOST_SIM
    } else {
#pragma unroll
        for (int ai = 0; ai < 2; ++ai)
#pragma unroll
            for (int m = 0; m < 4; ++m) { const float* s2 = sp + (long)(ai * 128 + m * 16) * 32; f32x4 a = *(const f32x4*)s2;
#pragma unroll
                for (int k = 1; k < 8; ++k) a += *(const f32x4*)(s2 + 4 * k);
                rsv[ai][m] = fuse_rs_fin(a); } }
#endif
}
HD void st_shp(const Params& p, long i) { const int col = (int)(i % NINP), r = (int)(i / NINP) % NMODROW, which = (int)(i / ((long)NINP * NMODROW));
    const int ncol = which == 2 ? NINP : NFI; if (col >= ncol) return;
    const float* sh = which == 2 ? wsp<float>(p, WS_MOD) + ((long)1 * NMODROW + r) * 6144 : wsp<float>(p, WS_MOD) + ((long)which * NMODROW + r) * 6144 + 3072;
    const bf16* w = which == 2 ? wsp<bf16>(p, WS_WTIN) + (size_t)1 * NINP * DM + (size_t)col * DM : wsp<bf16>(p, WS_WTFI) + (size_t)which * NFI * DM + (size_t)col * DM; float acc = 0.f;
    for (int k = 0; k < DM; ++k) acc += bf2f((bf16)f2bf(sh[k])) * bf2f(w[k]);
    wsp<float>(p, WS_SHP)[((long)which * 64 + r) * NINP + col] = acc; }

struct Unit { int pm, pn; };
HD void st8bf(bf16* dst, const float* v) { u32x4 w; w.x = pk2(v[0], v[1]); w.y = pk2(v[2], v[3]); w.z = pk2(v[4], v[5]); w.w = pk2(v[6], v[7]); *(u32x4*)dst = w; }
#define EPI_BEGIN \
    _Pragma("unroll") for (int ai = 0; ai < 2; ++ai) _Pragma("unroll") for (int m = 0; m < 4; ++m) _Pragma("unroll") for (int bj = 0; bj < 2; ++bj) { \
        const int row = u.pm * 256 + ai * 128 + wr * 64 + m * 16 + fr, col = u.pn * 256 + bj * 128 + wc * 32 + fq * 8; \
        float v[8]; _Pragma("unroll") for (int q_ = 0; q_ < 4; ++q_) { v[q_] = acc[ai][bj][m][0][q_]; v[4 + q_] = acc[ai][bj][m][1][q_]; }
#ifndef HOST_SIM
#define EPI_END asm volatile("" ::: "memory"); }
#else
#define EPI_END }
#endif

struct EpiInProj {
    static constexpr bool PERM = true, AFTER_DRAIN = false;
    Params p; int l, fused;
    HD void operator()(const f32x4 (&acc)[2][2][4][2], const Unit& u, int wr, int wc, int fr, int fq) const {
        const int pn = u.pn;
        float rsv[2][4]; f32x4 ha0 = {0.f, 0.f, 0.f, 0.f}, ha1 = ha0, hb0 = ha0, hb1 = ha0; const bool uni = u.pm < BT / 256;
        if (fused) { fuse_rs8(p, u.pm, wr, fr, rsv);
            if (uni) {
                const float* sh = wsp<float>(p, WS_SHP) + ((long)2 * 64 + (u.pm * 256) / T) * NINP + u.pn * 256 + wc * 32 + fq * 8; ha0 = *(const f32x4*)sh; ha1 = *(const f32x4*)(sh + 4); hb0 = *(const f32x4*)(sh + 128); hb1 = *(const f32x4*)(sh + 132); } }
        EPI_BEGIN {
            const RowInfo ri = rowinfo(row);
            if (fused) { const float rs = rsv[ai][m]; f32x4 h0 = bj == 0 ? ha0 : hb0, h1 = bj == 0 ? ha1 : hb1;
                if (!uni) { const float* sh = wsp<float>(p, WS_SHP) + ((long)2 * 64 + ri.modrow) * NINP + col; h0 = *(const f32x4*)sh; h1 = *(const f32x4*)(sh + 4); }
#pragma unroll
                for (int k = 0; k < 4; ++k) { v[k] = v[k] * rs + h0[k]; v[4 + k] = v[4 + k] * rs + h1[k]; } }
            if (pn < 2) { float s[8];
#pragma unroll
                for (int k = 0; k < 8; ++k) s[k] = v[k] * C2;
                st8bf(wsp<bf16>(p, WS_QB) + (long)row * 512 + col, s); }
            else if (pn < 5) { const int c = col - (512 + 256 * (pn - 2));
                float* o = nullptr;
                if (pn == 2) { if (ri.kind == 0) o = p.out + O_CMPP + (((long)l * NB + ri.b) * T + ri.t) * 256 + c; else if (ri.kind == 1) o = p.out + O_CMPS + (((long)l * DB + ri.b) * DS + ri.t) * 256 + c; }
                else if (pn == 3) { if (ri.kind == 0) o = p.out + O_SELP + (((long)l * NB + ri.b) * T + ri.t) * 256 + c; else if (ri.kind == 1) o = p.out + O_SELS + (((long)l * DB + ri.b) * DS + ri.t) * 256 + c;
                    st8bf(wsp<bf16>(p, WS_KVS) + (long)row * 256 + c, v); }
                else { if (ri.kind == 0) { if (ri.t >= T - WIN) o = p.out + O_WINP + (((long)l * NB + ri.b) * WIN + (ri.t - (T - WIN))) * 256 + c; } else if (ri.kind == 1) o = p.out + O_WINS + (((long)l * DB + ri.b) * WIN + (WIN - DS) + ri.t) * 256 + c;
                    st8bf(wsp<bf16>(p, WS_KVW) + (long)row * 256 + c, v); }
                if (o) { *(f32x4*)o = (f32x4){v[0], v[1], v[2], v[3]}; *(f32x4*)(o + 4) = (f32x4){v[4], v[5], v[6], v[7]}; } }
            else if (pn < 9) { const int q = col - 1280, seg = q / 512, r = q % 512, head = r / 128, i0 = 4 * ((r % 128) / 8); const float sc = seg == 0 ? 1.f : 0.08838834764831845f;
                bf16* dst = wsp<bf16>(p, seg == 0 ? WS_RQ : WS_RK) + (long)row * 512 + head * 128; unsigned w1[2], w2[2]; float o1[4], o2[4];
                const float* rot = wsp<float>(p, WS_ROT) + ((long)(ri.kind == 1 ? T + ri.t : ri.t) * 64 + i0) * 2;
                const f32x4 ra = *(const f32x4*)rot, rb = *(const f32x4*)(rot + 4); const float cs4[4] = {ra[0], ra[2], rb[0], rb[2]}, sn4[4] = {ra[1], ra[3], rb[1], rb[3]};
#pragma unroll
                for (int k = 0; k < 4; ++k) { const float cs = cs4[k], sn = sn4[k];
                    o1[k] = (v[k] * cs - v[4 + k] * sn) * sc; o2[k] = (v[k] * sn + v[4 + k] * cs) * sc; }
                w1[0] = pk2(o1[0], o1[1]); w1[1] = pk2(o1[2], o1[3]); w2[0] = pk2(o2[0], o2[1]); w2[1] = pk2(o2[2], o2[3]);
                *(unsigned long long*)(dst + i0) = (unsigned long long)w1[0] | ((unsigned long long)w1[1] << 32); *(unsigned long long*)(dst + 64 + i0) = (unsigned long long)w2[0] | ((unsigned long long)w2[1] << 32); }
            else if (pn < 13) st8bf(wsp<bf16>(p, WS_RV) + (long)row * DM + (col - 2304), v);
            else if (pn < 17) { float s[8];
#pragma unroll
                for (int k = 0; k < 8; ++k) s[k] = siluf_(v[k]);
                st8bf(wsp<bf16>(p, WS_SRG) + (long)row * DM + (col - 3328), s); }
            else if (pn < 25) { float s[8];
#pragma unroll
                for (int k = 0; k < 8; ++k) s[k] = sigmoidf_(v[k]);
                st8bf(wsp<bf16>(p, pn < 21 ? WS_SGA : WS_SGB) + (long)row * DM + (col - (pn < 21 ? 4352 : 5376)), s); }
            else { const int c = col - 6400; if (c < 24) { float* o = wsp<float>(p, WS_AG) + (long)row * 32 + c;
#pragma unroll
                    for (int k = 0; k < 8; ++k) o[k] = sigmoidf_(v[k]); } }
        } EPI_END
    }
};
HD void up8f(const bf16* src, float* f) { const u32x4 w = *(const u32x4*)src;
#pragma unroll
    for (int k = 0; k < 4; ++k) { f[2 * k] = __builtin_bit_cast(float, w[k] << 16); f[2 * k + 1] = __builtin_bit_cast(float, w[k] & 0xffff0000u); } }
struct EpiMixA {
    static constexpr bool PERM = true, AFTER_DRAIN = false;
    Params p;
    HD void operator()(const f32x4 (&acc)[2][2][4][2], const Unit& u, int wr, int wc, int fr, int fq) const {
        EPI_BEGIN { float g[8]; up8f(wsp<bf16>(p, WS_SGA) + (long)row * DM + col, g); float* o = wsp<float>(p, WS_MIXT) + (long)row * DM + col;
            *(f32x4*)o = (f32x4){g[0] * v[0], g[1] * v[1], g[2] * v[2], g[3] * v[3]}; *(f32x4*)(o + 4) = (f32x4){g[4] * v[4], g[5] * v[5], g[6] * v[6], g[7] * v[7]}; } EPI_END
    }
};
struct EpiMixB {
    static constexpr bool PERM = true, AFTER_DRAIN = false;
    Params p;
    HD void operator()(const f32x4 (&acc)[2][2][4][2], const Unit& u, int wr, int wc, int fr, int fq) const {
        EPI_BEGIN { float g[8]; up8f(wsp<bf16>(p, WS_SGB) + (long)row * DM + col, g); const float* t = wsp<float>(p, WS_MIXT) + (long)row * DM + col; const f32x4 t0 = *(const f32x4*)t, t1 = *(const f32x4*)(t + 4); float s[8];
#pragma unroll
            for (int k = 0; k < 4; ++k) { s[k] = t0[k] + g[k] * v[k]; s[4 + k] = t1[k] + g[4 + k] * v[4 + k]; }
            st8bf(wsp<bf16>(p, WS_MIX) + (long)row * DM + col, s); } EPI_END
    }
};
struct EpiResid {
    static constexpr bool PERM = true, AFTER_DRAIN = false;
    Params p; int l, goff, nkind, xin;
    HD void operator()(const f32x4 (&acc)[2][2][4][2], const Unit& u, int wr, int wc, int fr, int fq) const {
        float ssq = 0.f;
#ifndef HOST_SIM
        __attribute__((address_space(3))) float* ex = (__attribute__((address_space(3))) float*)(unsigned)132096;
#endif
        const bool uni = u.pm < BT / 256; f32x4 gg[2][2], ns[2][2];
#pragma unroll
        for (int b2 = 0; b2 < 2; ++b2)
#pragma unroll
            for (int hh = 0; hh < 2; ++hh) { gg[b2][hh] = (f32x4){0.f, 0.f, 0.f, 0.f}; ns[b2][hh] = gg[b2][hh]; }
        if (uni) { const int mr = (u.pm * 256) / T;
#pragma unroll
            for (int b2 = 0; b2 < 2; ++b2) { const int c0 = u.pn * 256 + b2 * 128 + wc * 32 + fq * 8; const float* g = wsp<float>(p, WS_MOD) + ((long)l * NMODROW + mr) * 6144 + goff + c0; gg[b2][0] = *(const f32x4*)g; gg[b2][1] = *(const f32x4*)(g + 4);
                if (nkind >= 0) { const float* nw = fuse_nw(p, l, nkind) + c0; const float* sc = fuse_sc(p, l, nkind, mr) + c0; ns[b2][0] = *(const f32x4*)nw * (*(const f32x4*)sc + 1.f); ns[b2][1] = *(const f32x4*)(nw + 4) * (*(const f32x4*)(sc + 4) + 1.f); } } }
#pragma unroll
        for (int ai = 0; ai < 2; ++ai)
#pragma unroll
            for (int m = 0; m < 4; ++m)
#pragma unroll
                for (int bj = 0; bj < 2; ++bj) {
                    const int row = u.pm * 256 + ai * 128 + wr * 64 + m * 16 + fr, col = u.pn * 256 + bj * 128 + wc * 32 + fq * 8;
                    f32x4 g0 = gg[bj][0], g1 = gg[bj][1], n0 = ns[bj][0], n1 = ns[bj][1];
                    if (!uni) { const RowInfo ri = rowinfo(row); const float* g = wsp<float>(p, WS_MOD) + ((long)l * NMODROW + ri.modrow) * 6144 + goff + col; g0 = *(const f32x4*)g; g1 = *(const f32x4*)(g + 4);
                        if (nkind >= 0) { const float* nw = fuse_nw(p, l, nkind) + col; const float* sc = fuse_sc(p, l, nkind, ri.modrow) + col; n0 = *(const f32x4*)nw * (*(const f32x4*)sc + 1.f); n1 = *(const f32x4*)(nw + 4) * (*(const f32x4*)(sc + 4) + 1.f); } }
                    float* x = wsp<float>(p, WS_X) + (long)row * DM + col;
                    const float* xs = xin ? (row < BT ? p.in[I_XP] + (long)row * DM : p.in[I_XS] + (long)(row < MREAL ? row - BT : 0) * DM) + col : x;
                    const f32x4 y0 = *(const f32x4*)xs + g0 * acc[ai][bj][m][0], y1 = *(const f32x4*)(xs + 4) + g1 * acc[ai][bj][m][1];
                    *(f32x4*)x = y0; *(f32x4*)(x + 4) = y1;
                    if (nkind >= 0) { const f32x4 h0 = y0 * n0, h1 = y1 * n1; float h[8];
#pragma unroll
                        for (int k = 0; k < 4; ++k) { h[k] = h0[k]; h[4 + k] = h1[k]; ssq += y0[k] * y0[k] + y1[k] * y1[k]; }
                        st8bf(wsp<bf16>(p, WS_XN) + (long)row * DM + col, h);
                        if (bj == 1) {
#ifdef HOST_SIM
                            float* sp = wsp<float>(p, WS_SSP) + (long)row * 32 + u.pn;
                            if (wc == 0 && fq == 0) *sp = ssq; else *sp += ssq;
#else
                            ssq += __shfl_xor(ssq, 16); ssq += __shfl_xor(ssq, 32); if (fq == 0) ex[(ai * 128 + wr * 64 + m * 16 + fr) * 4 + wc] = ssq;
#endif
                            ssq = 0.f; } } }
#ifndef HOST_SIM
        if (nkind >= 0) { asm volatile("s_waitcnt lgkmcnt(0)\n\ts_barrier" ::: "memory");
            const int t_ = wr * 256 + wc * 64 + fq * 16 + fr;
            if (t_ < 256) { const f32x4 e4 = *(const __attribute__((address_space(3))) f32x4*)(ex + t_ * 4); wsp<float>(p, WS_SSP)[(long)(u.pm * 256 + t_) * 32 + u.pn] = (e4[0] + e4[1]) + (e4[2] + e4[3]); }
            asm volatile("s_waitcnt lgkmcnt(0)\n\ts_barrier" ::: "memory"); }
#endif
    }
};
#ifndef HOST_SIM
__device__ __forceinline__ float dpp_prev(float prevgrp, float cur, int which  ) {
    const int pg = __builtin_bit_cast(int, prevgrp), cu = __builtin_bit_cast(int, cur);
    if (which == 1) { const int t = __builtin_amdgcn_update_dpp(pg, pg, 0x121, 0xf, 0xf, false); return __builtin_bit_cast(float, __builtin_amdgcn_update_dpp(t, cu, 0x111, 0xf, 0xf, false)); }
    const int t = __builtin_amdgcn_update_dpp(pg, pg, 0x122, 0xf, 0xf, false); return __builtin_bit_cast(float, __builtin_amdgcn_update_dpp(t, cu, 0x112, 0xf, 0xf, false));
}
#endif
struct EpiFfnIn {
    static constexpr bool PERM = true, AFTER_DRAIN = false;
    Params p; int l, fused;
    HD void operator()(const f32x4 (&acc)[2][2][4][2], const Unit& u, int wr, int wc, int fr, int fq) const {
        float rsv[2][4]; f32x4 ha0 = {0.f, 0.f, 0.f, 0.f}, ha1 = ha0, hb0 = ha0, hb1 = ha0; const bool uni = u.pm < BT / 256;
        if (fused) { fuse_rs8(p, u.pm, wr, fr, rsv);
            if (uni) {
                const float* sh = wsp<float>(p, WS_SHP) + ((long)l * 64 + (u.pm * 256) / T) * NINP + u.pn * 256 + wc * 32 + fq * 8; ha0 = *(const f32x4*)sh; ha1 = *(const f32x4*)(sh + 4); hb0 = *(const f32x4*)(sh + 128); hb1 = *(const f32x4*)(sh + 132); } }
#ifndef HOST_SIM
        if (uni && !fused) {
            const int c = u.pn * 128 + wc * 32 + fq * 8; const bool seq0 = (u.pm % (T / 256)) == 0;
            __attribute__((address_space(3))) float* hx = (__attribute__((address_space(3))) float*)(unsigned)(132096 + 4096);
            if (fr >= 14) {
#pragma unroll
                for (int ai = 0; ai < 2; ++ai) { __attribute__((address_space(3))) float* d = hx + ((ai * 2 + wr) * 4 + wc) * 64 + (fr - 14) * 32 + fq * 8;
                    *(__attribute__((address_space(3))) f32x4*)d = acc[ai][0][3][0]; *(__attribute__((address_space(3))) f32x4*)(d + 4) = acc[ai][0][3][1]; } }
            const float* cwp = p.in[I_FCW] + (long)l * 3 * DFF + c; const float* cbp = p.in[I_FCB] + l * DFF + c;
            f32x4 w0[2], w1[2], w2[2], bb[2];
#pragma unroll
            for (int hh = 0; hh < 2; ++hh) { w0[hh] = *(const f32x4*)(cwp + 4 * hh); w1[hh] = *(const f32x4*)(cwp + DFF + 4 * hh); w2[hh] = *(const f32x4*)(cwp + 2 * DFF + 4 * hh); bb[hh] = *(const f32x4*)(cbp + 4 * hh); }
            asm volatile("s_waitcnt lgkmcnt(0)\n\ts_barrier" ::: "memory");
#pragma unroll
            for (int ai = 0; ai < 2; ++ai)
#pragma unroll
                for (int m = 0; m < 4; ++m) {
                    const int row = u.pm * 256 + ai * 128 + wr * 64 + m * 16 + fr;
                    f32x4 pv0, pv1;
                    if (m > 0) { pv0 = acc[ai][0][m - 1][0]; pv1 = acc[ai][0][m - 1][1]; }
                    else if (ai == 0 && wr == 0) { pv0 = (f32x4){0.f, 0.f, 0.f, 0.f}; pv1 = pv0; }
                    else { const int pg = ai * 2 + wr - 1; const __attribute__((address_space(3))) float* d = hx + (pg * 4 + wc) * 64 + ((fr >= 14 ? fr : 14) - 14) * 32 + fq * 8;
                        pv0 = *(const __attribute__((address_space(3))) f32x4*)d; pv1 = *(const __attribute__((address_space(3))) f32x4*)(d + 4); }
                    const bool defer = (ai == 0 && wr == 0 && m == 0 && fr < 2 && !seq0);
                    float g[8]; float av[8]; float bv[8];
#pragma unroll
                    for (int k = 0; k < 8; ++k) { const float cur = acc[ai][0][m][k >> 2][k & 3], pg_ = (k < 4 ? pv0 : pv1)[k & 3];
                        const float p1 = dpp_prev(pg_, cur, 1), p2 = dpp_prev(pg_, cur, 2);
                        const float uu = bb[k >> 2][k & 3] + p2 * w0[k >> 2][k & 3] + p1 * w1[k >> 2][k & 3] + cur * w2[k >> 2][k & 3];
                        av[k] = cur; bv[k] = acc[ai][1][m][k >> 2][k & 3]; g[k] = geluf_(uu) * bv[k]; }
                    if (!defer) st8bf(wsp<bf16>(p, WS_G) + (long)row * DFF + c, g);
                    const bool first2 = (ai == 0 && wr == 0 && m == 0 && fr < 2), last2 = (ai == 1 && wr == 1 && m == 3 && fr >= 14);
                    if (first2 || last2) st8bf(wsp<bf16>(p, WS_FA) + (long)row * DFF + c, av);
                    if (first2) st8bf(wsp<bf16>(p, WS_FB) + (long)row * DFF + c, bv);
                    if (last2) { const RowInfo ri = rowinfo(row); if (ri.t >= T - 2) { float* o = p.out + O_CONVP + (((long)l * NB + ri.b) * 2 + (ri.t - (T - 2))) * DFF + c;
#pragma unroll
                            for (int k = 0; k < 8; ++k) o[k] = av[k]; } }
                }
            asm volatile("s_waitcnt lgkmcnt(0)\n\ts_barrier" ::: "memory");
            return;
        }
#endif
        EPI_BEGIN { const int c = u.pn * 128 + wc * 32 + fq * 8; const RowInfo ri = rowinfo(row);
            if (fused) { const float rs = rsv[ai][m]; f32x4 h0 = bj == 0 ? ha0 : hb0, h1 = bj == 0 ? ha1 : hb1;
                if (!uni) { const float* sh = wsp<float>(p, WS_SHP) + ((long)l * 64 + ri.modrow) * NINP + col; h0 = *(const f32x4*)sh; h1 = *(const f32x4*)(sh + 4); }
#pragma unroll
                for (int k = 0; k < 4; ++k) { v[k] = v[k] * rs + h0[k]; v[4 + k] = v[4 + k] * rs + h1[k]; } }
            st8bf(wsp<bf16>(p, bj == 0 ? WS_FA : WS_FB) + (long)row * DFF + c, v);
            if (bj == 0) { float* o = nullptr;
                if (ri.kind == 0 && ri.t >= T - 2) o = p.out + O_CONVP + (((long)l * NB + ri.b) * 2 + (ri.t - (T - 2))) * DFF + c;
                if (ri.kind == 1 && ri.t >= DS - 2) o = p.out + O_CONVS + (((long)l * DB + ri.b) * 2 + (ri.t - (DS - 2))) * DFF + c;
                if (o) {
#pragma unroll
                    for (int k = 0; k < 8; ++k) o[k] = v[k]; } } } EPI_END
    }
};

constexpr int PH_PER_LAYER = 16, N_PHASES = 2 + DEPTH * PH_PER_LAYER;

#ifndef HOST_SIM
constexpr int NTHR_ = 512;
#define LAS __attribute__((address_space(3)))
namespace pg8 {
#define PG8_LAS __attribute__((address_space(3)))
typedef unsigned short bf16_t;
typedef short bf16x8 __attribute__((ext_vector_type(8)));
constexpr int BM = 256, BK = 64, HALF = 128, HTB = HALF * BK * 2, STAGE_BYTES = 8 * HTB, NXCD = 8, WGM = 8;
__host__ __device__ __forceinline__ int lds_byte(int r, int c) { const int st = (r >> 4) * 2 + (c >> 5), rr = r & 15, cc = c & 31, ob = rr * 64 + cc * 2; return st * 1024 + (ob ^ (((ob >> 9) & 1) << 5)); }
__host__ __device__ __forceinline__ void stage_rc(int b, int& R, int& C) { const int st = b / 1024, sb = b % 1024, swz = sb ^ (((sb >> 9) & 1) << 5); R = (st >> 1) * 16 + swz / 64; C = (st & 1) * 32 + (swz % 64) / 2; }
__host__ __device__ __forceinline__ int perm32(int rho) { const int n = rho >> 4, i = rho & 15; return 8 * (i >> 2) + 4 * n + (i & 3); }
struct Gemm { const bf16_t* A; const bf16_t* Bt; int M, N, K; };
struct StaticOrder {
    int nM, nN, nwg, G, c;
    __host__ __device__ void init(int M, int N, int G_, int c_) { nM = M / BM; nN = N / BM; nwg = nM * nN; G = G_; c = c_; }
    __host__ __device__ bool next(int i, Unit& u) const {
        const long L = (long)i * G + c; if (L >= nwg) return false;
        int wgid = (int)L; { const int q = nwg / NXCD, r = nwg % NXCD, xcd = wgid % NXCD, off = wgid / NXCD; wgid = (xcd < r ? xcd * (q + 1) : r * (q + 1) + (xcd - r) * q) + off; }
        const int nig = WGM * nN, gid = wgid / nig, fm = gid * WGM, gsz = (nM - fm) < WGM ? (nM - fm) : WGM;
        u.pm = fm + ((wgid % nig) % gsz); u.pn = (wgid % nig) / gsz; return true;
    }
    __device__ __forceinline__ void a_ready(const Unit&) const {}
    __device__ __forceinline__ void done(const Unit&) const {}
};
template <class Epi, class Sched, bool ALIGN_EPI = false, bool SP2 = false>
__device__ __forceinline__ void gemm_phase(PG8_LAS unsigned char* lds, const Gemm g, const Sched& S, const Epi& E) {
    int tid_ = threadIdx.x; asm volatile("" : "+v"(tid_));
    const int tid = tid_, wid = __builtin_amdgcn_readfirstlane(tid >> 6), lane = tid & 63, wr = wid >> 2, wc = wid & 3, fr = lane & 15, fq = lane >> 4;
    const int K = g.K, nt = K / BK;
    unsigned voffA[2], voffB[2];
#pragma unroll
    for (int i = 0; i < 2; ++i) { int R, C; stage_rc(tid * 16 + i * 8192, R, C); const int Rb = Epi::PERM ? ((R & ~31) + perm32(R & 31)) : R;
        voffA[i] = (unsigned)(R * K + C) * 2u; voffB[i] = (unsigned)(Rb * K + C) * 2u; }
    const size_t kstep = (size_t)(BK * 2);
    const size_t hstep = (size_t)HALF * K * 2;
    const size_t tstep = 2 * hstep;
    const unsigned ldsw = (unsigned)wid * 1024u;
    const int aoff = lds_byte(wr * 64 + fr, fq * 8), boff = lds_byte(wc * 32 + fr, fq * 8);
#define PG8_SA(b, h) (((b) * 2 + (h)) * HTB)
#define PG8_SB(b, h) ((4 + (b) * 2 + (h)) * HTB)
#define PG8_STAGE(bufoff, gbase, voff) do { _Pragma("unroll") for (int _i = 0; _i < 2; ++_i) \
        __builtin_amdgcn_global_load_lds((const unsigned*)((const char*)(gbase) + (voff)[_i]), (PG8_LAS unsigned*)(lds + (bufoff) + ldsw + _i * 8192), 16, 0, 0); } while (0)
#define PG8_LDA(dst, b, h) do { _Pragma("unroll") for (int m = 0; m < 4; ++m) _Pragma("unroll") for (int k = 0; k < 2; ++k) dst[m][k] = *(const PG8_LAS bf16x8*)(lds + PG8_SA(b, h) + aoff + m * 2048 + k * 1024); } while (0)
#define PG8_LDB(dst, b, h) do { _Pragma("unroll") for (int n = 0; n < 2; ++n) _Pragma("unroll") for (int k = 0; k < 2; ++k) dst[n][k] = *(const PG8_LAS bf16x8*)(lds + PG8_SB(b, h) + boff + n * 2048 + k * 1024); } while (0)
#define PG8_MMA(ai, bj, At, Bt) do { __builtin_amdgcn_s_setprio(1); _Pragma("unroll") for (int m = 0; m < 4; ++m) _Pragma("unroll") for (int n = 0; n < 2; ++n) _Pragma("unroll") for (int k = 0; k < 2; ++k) \
        acc[ai][bj][m][n] = __builtin_amdgcn_mfma_f32_16x16x32_bf16(Bt[n][k], At[m][k], acc[ai][bj][m][n], 0, 0, 0); __builtin_amdgcn_s_setprio(0); } while (0)
#define PG8_WAIT_V(n) asm volatile("s_waitcnt vmcnt(" #n ")" ::: "memory")
#define PG8_WAIT_L(n) asm volatile("s_waitcnt lgkmcnt(" #n ")" ::: "memory")
#define PG8_BAR __builtin_amdgcn_s_barrier()
#define PG8_SCHED __builtin_amdgcn_sched_barrier(0)
    Unit cur, nxt; int ui = 0;
    if (!S.next(0, cur)) return;
    f32x4 acc[2][2][4][2];
#pragma unroll
    for (int a = 0; a < 2; ++a)
#pragma unroll
        for (int b = 0; b < 2; ++b)
#pragma unroll
            for (int m = 0; m < 4; ++m)
#pragma unroll
                for (int n = 0; n < 2; ++n) acc[a][b][m][n] = (f32x4){0.f, 0.f, 0.f, 0.f};
    bf16x8 At[4][2], B0[2][2], B1[2][2];
    const char* cA = (const char*)g.A + (size_t)cur.pm * tstep; const char* cB = (const char*)g.Bt + (size_t)cur.pn * tstep;
    S.a_ready(cur);
    if constexpr (SP2) {
        PG8_STAGE(PG8_SB(0, 0), cB, voffB); PG8_STAGE(PG8_SB(0, 1), cB + hstep, voffB); PG8_STAGE(PG8_SA(0, 0), cA, voffA); PG8_STAGE(PG8_SA(0, 1), cA + hstep, voffA);
        if (wr == 1) PG8_BAR;
        PG8_WAIT_V(2); PG8_BAR;
        PG8_STAGE(PG8_SB(1, 0), cB + kstep, voffB); PG8_STAGE(PG8_SA(1, 0), cA + kstep, voffA); PG8_STAGE(PG8_SB(1, 1), cB + hstep + kstep, voffB);
        PG8_WAIT_V(6); PG8_BAR;
    } else {
        PG8_STAGE(PG8_SB(0, 0), cB, voffB); PG8_STAGE(PG8_SA(0, 0), cA, voffA); PG8_STAGE(PG8_SB(0, 1), cB + hstep, voffB); PG8_STAGE(PG8_SA(0, 1), cA + hstep, voffA);
        if (wr == 1) PG8_BAR;
        PG8_WAIT_V(4); PG8_BAR;
        PG8_STAGE(PG8_SB(1, 0), cB + kstep, voffB); PG8_STAGE(PG8_SA(1, 0), cA + kstep, voffA); PG8_STAGE(PG8_SB(1, 1), cB + hstep + kstep, voffB);
        PG8_WAIT_V(6); PG8_BAR;
    }
    for (;;) {
        const bool has_next = S.next(ui + 1, nxt);
        const char* nA = has_next ? (const char*)g.A + (size_t)nxt.pm * tstep : cA; const char* nB = has_next ? (const char*)g.Bt + (size_t)nxt.pn * tstep : cB;
        for (int t = 0; t < nt; t += 2) {
            const bool last = (t == nt - 2);
            const char* a1 = cA + (size_t)(t + 1) * kstep;
            const char* a2 = last ? nA : cA + (size_t)(t + 2) * kstep; const char* b2 = last ? nB : cB + (size_t)(t + 2) * kstep;
            const char* a3 = a2 + kstep; const char* b3 = b2 + kstep;
            if (last && has_next) S.a_ready(nxt);
            if constexpr (SP2) {
            PG8_LDB(B0, 0, 0); PG8_LDB(B1, 0, 1); PG8_SCHED; PG8_LDA(At, 0, 0); PG8_STAGE(PG8_SA(1, 1), a1 + hstep, voffA);
            PG8_WAIT_V(8); PG8_WAIT_L(0); PG8_BAR; PG8_MMA(0, 0, At, B0); PG8_MMA(0, 1, At, B1); PG8_BAR; PG8_SCHED;
            PG8_LDA(At, 0, 1); PG8_STAGE(PG8_SB(0, 0), b2, voffB); PG8_STAGE(PG8_SB(0, 1), b2 + hstep, voffB); PG8_STAGE(PG8_SA(0, 0), a2, voffA);
            PG8_WAIT_V(8); PG8_WAIT_L(0); PG8_BAR; PG8_MMA(1, 0, At, B0); PG8_MMA(1, 1, At, B1); PG8_BAR; PG8_SCHED;
            PG8_LDB(B0, 1, 0); PG8_LDB(B1, 1, 1); PG8_SCHED; PG8_LDA(At, 1, 0); PG8_STAGE(PG8_SA(0, 1), a2 + hstep, voffA);
            PG8_WAIT_V(8); PG8_WAIT_L(0); PG8_BAR; PG8_MMA(0, 0, At, B0); PG8_MMA(0, 1, At, B1); PG8_BAR; PG8_SCHED;
            PG8_LDA(At, 1, 1); PG8_STAGE(PG8_SB(1, 0), b3, voffB); PG8_STAGE(PG8_SB(1, 1), b3 + hstep, voffB); PG8_STAGE(PG8_SA(1, 0), a3, voffA);
            PG8_WAIT_V(8); PG8_WAIT_L(0); PG8_BAR; PG8_MMA(1, 0, At, B0); PG8_MMA(1, 1, At, B1); PG8_BAR; PG8_SCHED;
            } else {
            PG8_LDB(B0, 0, 0); PG8_SCHED; PG8_LDA(At, 0, 0); PG8_STAGE(PG8_SA(1, 1), a1 + hstep, voffA);
            PG8_WAIT_L(8); PG8_BAR; PG8_WAIT_L(0); PG8_MMA(0, 0, At, B0); PG8_BAR; PG8_SCHED;
            PG8_LDB(B1, 0, 1); PG8_STAGE(PG8_SB(0, 0), b2, voffB);
            PG8_BAR; PG8_WAIT_L(0); PG8_MMA(0, 1, At, B1); PG8_BAR;
            PG8_LDA(At, 0, 1); PG8_STAGE(PG8_SA(0, 0), a2, voffA);
            PG8_BAR; PG8_WAIT_L(0); PG8_MMA(1, 0, At, B0); PG8_BAR; PG8_SCHED;
            PG8_STAGE(PG8_SB(0, 1), b2 + hstep, voffB);
            PG8_WAIT_V(6); PG8_BAR; PG8_MMA(1, 1, At, B1); PG8_BAR;
            PG8_LDB(B0, 1, 0); PG8_SCHED; PG8_LDA(At, 1, 0); PG8_STAGE(PG8_SA(0, 1), a2 + hstep, voffA);
            PG8_WAIT_L(8); PG8_BAR; PG8_WAIT_L(0); PG8_MMA(0, 0, At, B0); PG8_BAR; PG8_SCHED;
            PG8_LDB(B1, 1, 1); PG8_STAGE(PG8_SB(1, 0), b3, voffB);
            PG8_BAR; PG8_WAIT_L(0); PG8_MMA(0, 1, At, B1); PG8_BAR;
            PG8_LDA(At, 1, 1); PG8_STAGE(PG8_SA(1, 0), a3, voffA);
            PG8_BAR; PG8_WAIT_L(0); PG8_MMA(1, 0, At, B0); PG8_BAR; PG8_SCHED;
            PG8_STAGE(PG8_SB(1, 1), b3 + hstep, voffB);
            PG8_WAIT_V(6); PG8_BAR; PG8_MMA(1, 1, At, B1); PG8_BAR;
            }
        }
        if constexpr (ALIGN_EPI) { if (wr == 0) PG8_BAR; }
        if constexpr (!Epi::AFTER_DRAIN) { E(acc, cur, wr, wc, fr, fq); S.done(cur); }
        if (!has_next) break;
#pragma unroll
        for (int a = 0; a < 2; ++a)
#pragma unroll
            for (int b = 0; b < 2; ++b)
#pragma unroll
                for (int m = 0; m < 4; ++m)
#pragma unroll
                    for (int n = 0; n < 2; ++n) acc[a][b][m][n] = (f32x4){0.f, 0.f, 0.f, 0.f};
        cur = nxt; cA = nA; cB = nB; ++ui;
        if constexpr (ALIGN_EPI) { if (wr == 1) PG8_BAR; }
    }
    PG8_WAIT_V(0);
    if constexpr (!ALIGN_EPI) { if (wr == 0) PG8_BAR; }
    PG8_BAR;
#undef PG8_SA
#undef PG8_SB
#undef PG8_STAGE
#undef PG8_LDA
#undef PG8_LDB
#undef PG8_MMA
#undef PG8_WAIT_V
#undef PG8_WAIT_L
#undef PG8_BAR
#undef PG8_SCHED
}
}


#define LDS_BAR() asm volatile("s_waitcnt lgkmcnt(0)\n\ts_barrier" ::: "memory")
namespace fa {
typedef short bf16x8 __attribute__((ext_vector_type(8)));
typedef short s16x4 __attribute__((ext_vector_type(4)));
typedef short v4i16_t __attribute__((ext_vector_type(4)));
typedef float f32x16 __attribute__((ext_vector_type(16)));
typedef float f32x2_t __attribute__((ext_vector_type(2)));
typedef __bf16 bf16x2_t __attribute__((ext_vector_type(2)));
#define FA_LAS __attribute__((address_space(3)))
constexpr int K0 = 0, K1 = 8192, V0 = 16384, V1 = 24576, WSCR = 65536;
constexpr float MASKV = -3e30f, MINIT = -1e30f;
__device__ __forceinline__ int crow(int r, int hi) { return (r & 3) + 8 * (r >> 2) + 4 * hi; }
__device__ __forceinline__ float swapmax(float v) { auto rr = __builtin_amdgcn_permlane32_swap(__float_as_uint(v), __float_as_uint(v), false, false); return fmaxf(__uint_as_float(rr[0]), __uint_as_float(rr[1])); }
__device__ __forceinline__ float swapsum(float v) { auto rr = __builtin_amdgcn_permlane32_swap(__float_as_uint(v), __float_as_uint(v), false, false); return __uint_as_float(rr[0]) + __uint_as_float(rr[1]); }
__device__ __forceinline__ float partner(float v, int hi) { auto rr = __builtin_amdgcn_permlane32_swap(__float_as_uint(v), __float_as_uint(v), false, false); return hi ? __uint_as_float(rr[0]) : __uint_as_float(rr[1]); }
__device__ __forceinline__ unsigned cvtpk(float lo, float hi) { f32x2_t v = {lo, hi}; bf16x2_t b = __builtin_convertvector(v, bf16x2_t); return __builtin_bit_cast(unsigned, b); }
struct TileRegs { u32x4 k, v; };
__device__ __forceinline__ void tile_load(TileRegs& tr, const bf16* base, int wid, int lane) {
    tr.k = *(const u32x4*)(base + (long)lane * 256 + wid * 8);
    tr.v = *(const u32x4*)(base + 128 + (long)(16 * (wid & 3) + (lane >> 2)) * 256 + (wid >> 2) * 32 + (lane & 3) * 8);
}
__device__ __forceinline__ void tile_store(const TileRegs& tr, FA_LAS unsigned char* lds, int kb, int vb, int wid, int lane) {
    *(FA_LAS u32x4*)(lds + kb + wid * 1024 + lane * 16) = tr.k;
    *(FA_LAS u32x4*)(lds + vb + wid * 1024 + lane * 16) = tr.v;
}
__device__ __forceinline__ void qkt(f32x16& p0, f32x16& p1, FA_LAS const unsigned char* kslot, const bf16x8* qr, int r32, int hi) {
    FA_LAS const unsigned char* kb = kslot + hi * 1024 + r32 * 16;
#pragma unroll
    for (int r = 0; r < 16; ++r) { p0[r] = 0.f; p1[r] = 0.f; }
#pragma unroll
    for (int d0 = 0; d0 < 4; ++d0) {
        const bf16x8 b0 = *(FA_LAS const bf16x8*)(kb + d0 * 2048), b1 = *(FA_LAS const bf16x8*)(kb + d0 * 2048 + 512);
        p0 = __builtin_amdgcn_mfma_f32_32x32x16_bf16(b0, qr[d0], p0, 0, 0, 0);
        p1 = __builtin_amdgcn_mfma_f32_32x32x16_bf16(b1, qr[d0], p1, 0, 0, 0);
    }
}
__device__ __forceinline__ void pvt(f32x16* o, FA_LAS const unsigned char* vslot, int lane, int hi, const f32x16& p0, const f32x16& p1) {
    FA_LAS const unsigned char* vp = vslot + ((lane >> 4) & 1) * 32 + (lane & 3) * 8 + (4 * hi + ((lane & 15) >> 2)) * 64;
    u32x4 pw[4];
#pragma unroll
    for (int k = 0; k < 4; ++k) { pw[0][k] = cvtpk(p0[2 * k], p0[2 * k + 1]); pw[1][k] = cvtpk(p0[8 + 2 * k], p0[9 + 2 * k]); pw[2][k] = cvtpk(p1[2 * k], p1[2 * k + 1]); pw[3][k] = cvtpk(p1[8 + 2 * k], p1[9 + 2 * k]); }
#pragma unroll
    for (int d0 = 0; d0 < 2; ++d0)
#pragma unroll
        for (int ks = 0; ks < 4; ++ks) {
            const s16x4 lo = __builtin_bit_cast(s16x4, __builtin_amdgcn_ds_read_tr16_b64_v4i16((FA_LAS v4i16_t*)(vp + d0 * 4096 + ks * 1024)));
            const s16x4 hh = __builtin_bit_cast(s16x4, __builtin_amdgcn_ds_read_tr16_b64_v4i16((FA_LAS v4i16_t*)(vp + d0 * 4096 + ks * 1024 + 512)));
            const bf16x8 vf = (bf16x8){lo[0], lo[1], lo[2], lo[3], hh[0], hh[1], hh[2], hh[3]};
            o[d0] = __builtin_amdgcn_mfma_f32_32x32x16_bf16(vf, __builtin_bit_cast(bf16x8, pw[ks]), o[d0], 0, 0, 0);
        }
}
__device__ __forceinline__ void attn_prompt_unit(const Params& q, int b, int g, int ib, FA_LAS unsigned char* lds) {
    int tid_ = threadIdx.x; asm volatile("" : "+v"(tid_));
    const int tid = tid_, lane = tid & 63, r32 = lane & 31, hi = lane >> 5, wid = __builtin_amdgcn_readfirstlane(tid >> 6);
    const int tq = 8 * wid + (r32 >> 2), hq = r32 & 3, head = 4 * g + hq;
    const long m = (long)b * T + 64 * ib + tq;
    const bf16* qp = wsp<bf16>(q, WS_QB) + m * 512 + head * 64;
    bf16x8 qr[4];
#pragma unroll
    for (int d0 = 0; d0 < 4; ++d0) qr[d0] = *(const bf16x8*)(qp + 16 * d0 + 8 * hi);
    const float* agp = wsp<float>(q, WS_AG) + m * 32 + head * 3;
    const float gc = agp[0], gs = agp[1], gw = agp[2];
    f32x16 res[2];
#pragma unroll
    for (int r = 0; r < 16; ++r) { res[0][r] = 0.f; res[1][r] = 0.f; }
    FA_LAS unsigned char* wscr = lds + WSCR + wid * 2048;
    FA_LAS float* impb = (FA_LAS float*)wscr; FA_LAS unsigned* maskb = (FA_LAS unsigned*)(wscr + 1024);
    const bf16* kvs = wsp<bf16>(q, WS_KVS) + ((long)b * T) * 256 + g * 64;
    const bf16* kvw = wsp<bf16>(q, WS_KVW) + ((long)b * T) * 256 + g * 64;
    { const bf16* kc = wsp<bf16>(q, WS_KC) + (long)(b * 128) * 256 + g * 64;
      TileRegs t0, t1; tile_load(t0, kc, wid, lane); tile_load(t1, kc + 64 * 256, wid, lane);
      tile_store(t0, lds, K0, V0, wid, lane); tile_store(t1, lds, K1, V1, wid, lane); }
    __syncthreads();
    TileRegs nx; tile_load(nx, kvs, wid, lane);
    {
        f32x16 s[4]; qkt(s[0], s[1], lds + K0, qr, r32, hi); qkt(s[2], s[3], lds + K1, qr, r32, hi);
        const int qpos = 64 * ib + tq; const int nmax = qpos >= 31 ? ((qpos - 31) >> 4) : -1; const bool have = nmax >= 0;
        float mx = MASKV;
#pragma unroll
        for (int t4 = 0; t4 < 4; ++t4)
#pragma unroll
            for (int r = 0; r < 16; ++r) { const int n = 32 * t4 + crow(r, hi); const float v = n <= nmax ? s[t4][r] : MASKV; s[t4][r] = v; mx = fmaxf(mx, v); }
        mx = swapmax(mx);
        float ls = 0.f;
#pragma unroll
        for (int t4 = 0; t4 < 4; ++t4)
#pragma unroll
            for (int r = 0; r < 16; ++r) { const float e = have ? __builtin_amdgcn_exp2f(s[t4][r] - mx) : 0.f; s[t4][r] = e; ls += e; }
        ls = swapsum(ls);
        const float inv = have ? 1.f / ls : 0.f;
        if (ib >= 16) {
            float G[16], E[16];
#pragma unroll
            for (int t4 = 0; t4 < 4; ++t4)
#pragma unroll
                for (int a = 0; a < 4; ++a) { G[t4 * 4 + a] = ((s[t4][4 * a] + s[t4][4 * a + 1]) + (s[t4][4 * a + 2] + s[t4][4 * a + 3])) * inv; E[t4 * 4 + a] = s[t4][4 * a + 3] * inv; }
            float Ep[16];
#pragma unroll
            for (int k = 0; k < 16; ++k) Ep[k] = partner(E[k], hi);
#pragma unroll
            for (int k = 0; k < 16; ++k) { const float add = hi ? Ep[k] : (k > 0 ? Ep[k > 0 ? k - 1 : 0] : 0.f); G[k] += add; }
#pragma unroll
            for (int k = 0; k < 16; ++k) { G[k] += __shfl_xor(G[k], 1); G[k] += __shfl_xor(G[k], 2); }
            if (hq == 0) {
#pragma unroll
                for (int k = 0; k < 16; ++k) impb[(r32 >> 2) * 32 + 8 * (k >> 2) + 2 * (k & 3) + hi] = G[k]; }
        }
        f32x16 o[2];
#pragma unroll
        for (int r = 0; r < 16; ++r) { o[0][r] = 0.f; o[1][r] = 0.f; }
        pvt(o, lds + V0, lane, hi, s[0], s[1]); pvt(o, lds + V1, lane, hi, s[2], s[3]);
        const float sc = gc * inv;
#pragma unroll
        for (int r = 0; r < 16; ++r) { res[0][r] += o[0][r] * sc; res[1][r] += o[1][r] * sc; }
    }
    unsigned selmask;
    if (ib < 16) selmask = 0xffffffffu >> (31 - ib);
    else {
#pragma unroll 1
        for (int pass = 0; pass < 4; ++pass) { const int tl = 2 * pass + hi, j = r32; const float v = impb[tl * 32 + j]; int rank = 0;
            for (int jj = 1; jj <= ib - 2; ++jj) { const float t = impb[tl * 32 + jj]; rank += (t > v || (t == v && jj < j)) ? 1 : 0; }
            const bool forced = (j == 0) || (j == ib) || (j == ib - 1), cand = (j >= 1) && (j <= ib - 2);
            const bool sel = forced || (cand && rank < 13);
            const unsigned long long bal = __ballot(sel);
            if (lane == 0) { maskb[2 * pass] = (unsigned)bal; maskb[2 * pass + 1] = (unsigned)(bal >> 32); } }
        selmask = maskb[r32 >> 2];
    }
    const int nB = ib + 1, jw0 = ib >= 8 ? ib - 8 : 0, nT = nB + (ib - jw0 + 1);
    float mrun = MINIT, lrun = 0.f, lfold = 0.f; f32x16 o[2];
#pragma unroll
    for (int r = 0; r < 16; ++r) { o[0][r] = 0.f; o[1][r] = 0.f; }
#define FA_SRC(t1) ((t1) < nB ? kvs + (long)(64 * (t1)) * 256 : kvw + (long)(64 * (jw0 + (t1) - nB)) * 256)
#define FA_KS(t1) (((t1) & 3) * 16384)
#define FA_VS(t1) (((t1) & 3) * 16384 + 8192)
    TileRegs ny; tile_load(ny, FA_SRC(1), wid, lane);
    __syncthreads();
    tile_store(nx, lds, FA_KS(0), FA_VS(0), wid, lane); tile_store(ny, lds, FA_KS(1), FA_VS(1), wid, lane);
    if (2 < nT) tile_load(nx, FA_SRC(2), wid, lane);
    __syncthreads();
    f32x16 sc0, sc1; qkt(sc0, sc1, lds + FA_KS(0), qr, r32, hi);
    u32x4 pwp[4];
#pragma unroll
    for (int k = 0; k < 4; ++k) pwp[k] = (u32x4){0u, 0u, 0u, 0u};
#pragma unroll 1
    for (int t = 0; t < nT; ++t) {
        if (t + 2 < nT) { tile_store(nx, lds, FA_KS(t + 2), FA_VS(t + 2), wid, lane); if (t + 3 < nT) tile_load(nx, FA_SRC(t + 3), wid, lane); }
        if (t == nB) {
            lfold = lrun; mrun = MINIT; lrun = 0.f; }
        const bool isB = t < nB; const int j = isB ? t : jw0 + (t - nB);
        if (j == ib) { asm volatile("; diagonal tile" ::: "memory");
#pragma unroll
            for (int r = 0; r < 16; ++r) { const int key = crow(r, hi); if (key > tq) sc0[r] = MASKV; if (key + 32 > tq) sc1[r] = MASKV; } }
        if (!isB && ib >= 8 && j == jw0) { asm volatile("; oldest window tile" ::: "memory");
#pragma unroll
            for (int r = 0; r < 16; ++r) { const int key = crow(r, hi); if (key <= tq) sc0[r] = MASKV; if (key + 32 <= tq) sc1[r] = MASKV; } }
        const bool lanesel = isB ? ((selmask >> j) & 1u) != 0u : true;
        const int tn = t + 1 < nT ? t + 1 : t, tp = t >= 1 ? t - 1 : 0;
        FA_LAS const unsigned char* kb = lds + FA_KS(tn) + hi * 1024 + r32 * 16;
        FA_LAS const unsigned char* vp = lds + FA_VS(tp) + ((lane >> 4) & 1) * 32 + (lane & 3) * 8 + (4 * hi + ((lane & 15) >> 2)) * 64;
        bf16x8 kf[8];
#pragma unroll
        for (int d0 = 0; d0 < 4; ++d0) { kf[2 * d0] = *(FA_LAS const bf16x8*)(kb + d0 * 2048); kf[2 * d0 + 1] = *(FA_LAS const bf16x8*)(kb + d0 * 2048 + 512); }
        bf16x8 vf[8];
#pragma unroll
        for (int i = 0; i < 8; ++i) { const int d0 = i >> 2, ks = i & 3;
            const s16x4 lo = __builtin_bit_cast(s16x4, __builtin_amdgcn_ds_read_tr16_b64_v4i16((FA_LAS v4i16_t*)(vp + d0 * 4096 + ks * 1024)));
            const s16x4 hh = __builtin_bit_cast(s16x4, __builtin_amdgcn_ds_read_tr16_b64_v4i16((FA_LAS v4i16_t*)(vp + d0 * 4096 + ks * 1024 + 512)));
            vf[i] = (bf16x8){lo[0], lo[1], lo[2], lo[3], hh[0], hh[1], hh[2], hh[3]}; }
        f32x16 sn0, sn1;
#pragma unroll
        for (int r = 0; r < 16; ++r) { sn0[r] = 0.f; sn1[r] = 0.f; }
#pragma unroll
        for (int d0 = 0; d0 < 4; ++d0) { sn0 = __builtin_amdgcn_mfma_f32_32x32x16_bf16(kf[2 * d0], qr[d0], sn0, 0, 0, 0); sn1 = __builtin_amdgcn_mfma_f32_32x32x16_bf16(kf[2 * d0 + 1], qr[d0], sn1, 0, 0, 0); }
#pragma unroll
        for (int i = 0; i < 8; ++i) o[i >> 2] = __builtin_amdgcn_mfma_f32_32x32x16_bf16(vf[i], __builtin_bit_cast(bf16x8, pwp[i & 3]), o[i >> 2], 0, 0, 0);
        float mt = fmaxf(sc0[0], sc1[0]);
#pragma unroll
        for (int r = 1; r < 16; ++r) mt = fmaxf(mt, fmaxf(sc0[r], sc1[r]));
        mt = swapmax(mt); if (!lanesel) mt = MASKV;
        const float mnew = fmaxf(mrun, mt); const float msub = lanesel ? mnew : 3e38f; float ls = 0.f;
#pragma unroll
        for (int r = 0; r < 16; ++r) { sc0[r] = __builtin_amdgcn_exp2f(sc0[r] - msub); sc1[r] = __builtin_amdgcn_exp2f(sc1[r] - msub); ls += sc0[r] + sc1[r]; }
#pragma unroll
        for (int k = 0; k < 4; ++k) { pwp[0][k] = cvtpk(sc0[2 * k], sc0[2 * k + 1]); pwp[1][k] = cvtpk(sc0[8 + 2 * k], sc0[9 + 2 * k]); pwp[2][k] = cvtpk(sc1[2 * k], sc1[2 * k + 1]); pwp[3][k] = cvtpk(sc1[8 + 2 * k], sc1[9 + 2 * k]); }
        if (t == nB) { asm volatile("; fold" ::: "memory"); const float sc = gs / swapsum(lfold);
#pragma unroll
            for (int r = 0; r < 16; ++r) { res[0][r] += o[0][r] * sc; res[1][r] += o[1][r] * sc; o[0][r] = 0.f; o[1][r] = 0.f; } }
        if (__any(mnew > mrun)) { asm volatile("; rescale" ::: "memory"); const float alpha = __builtin_amdgcn_exp2f(mrun - mnew); lrun *= alpha;
#pragma unroll
            for (int r = 0; r < 16; ++r) { o[0][r] *= alpha; o[1][r] *= alpha; } }
        mrun = mnew; lrun += ls;
        sc0 = sn0; sc1 = sn1;
        LDS_BAR();
    }
    {
        FA_LAS const unsigned char* vp = lds + FA_VS(nT - 1) + ((lane >> 4) & 1) * 32 + (lane & 3) * 8 + (4 * hi + ((lane & 15) >> 2)) * 64;
#pragma unroll
        for (int d0 = 0; d0 < 2; ++d0)
#pragma unroll
            for (int ks = 0; ks < 4; ++ks) {
                const s16x4 lo = __builtin_bit_cast(s16x4, __builtin_amdgcn_ds_read_tr16_b64_v4i16((FA_LAS v4i16_t*)(vp + d0 * 4096 + ks * 1024)));
                const s16x4 hh = __builtin_bit_cast(s16x4, __builtin_amdgcn_ds_read_tr16_b64_v4i16((FA_LAS v4i16_t*)(vp + d0 * 4096 + ks * 1024 + 512)));
                const bf16x8 vf = (bf16x8){lo[0], lo[1], lo[2], lo[3], hh[0], hh[1], hh[2], hh[3]};
                o[d0] = __builtin_amdgcn_mfma_f32_32x32x16_bf16(vf, __builtin_bit_cast(bf16x8, pwp[ks]), o[d0], 0, 0, 0); }
        const float sc = gw / swapsum(lrun);
#pragma unroll
        for (int r = 0; r < 16; ++r) { res[0][r] += o[0][r] * sc; res[1][r] += o[1][r] * sc; }
    }
    LDS_BAR();
#undef FA_SRC
#undef FA_KS
#undef FA_VS
    bf16* op = wsp<bf16>(q, WS_OA) + m * 512 + head * 64;
#pragma unroll
    for (int d0 = 0; d0 < 2; ++d0)
#pragma unroll
        for (int a = 0; a < 4; ++a) { const unsigned w0 = cvtpk(res[d0][4 * a], res[d0][4 * a + 1]), w1 = cvtpk(res[d0][4 * a + 2], res[d0][4 * a + 3]);
            *(unsigned long long*)(op + 32 * d0 + 8 * a + 4 * hi) = (unsigned long long)w0 | ((unsigned long long)w1 << 32); }
}
__device__ __forceinline__ void attn_prompt_phase(const Params& q, FA_LAS unsigned char* lds) {
    const int G = gridDim.x, bx = blockIdx.x; const int vcu = (G % 8 == 0) ? (bx % 8) * (G / 8) + bx / 8 : bx;
    for (int u = vcu; u < NB * 2 * 16; u += G) { const int bg = u / 16, s = u % 16; attn_prompt_unit(q, bg / 2, bg % 2, s, lds); attn_prompt_unit(q, bg / 2, bg % 2, 31 - s, lds); }
}
}


namespace rt {
using fa::bf16x8; using fa::s16x4; using fa::v4i16_t; using fa::f32x16; using fa::cvtpk; using fa::crow;
__device__ __forceinline__ int tr_off(int row, int c8, int R16) { return ((c8 >> 2) * R16 + (row >> 4)) * 1024 + (row & 15) * 64 + (c8 & 3) * 16; }
__device__ __forceinline__ bf16x8 trfrag(FA_LAS const unsigned char* tile, int R16, int cb, int ks, int lane, int hi) {
    FA_LAS const unsigned char* vp = tile + (cb * R16 + ks) * 1024 + ((lane >> 4) & 1) * 32 + (lane & 3) * 8 + (4 * hi + ((lane & 15) >> 2)) * 64;
    const s16x4 lo = __builtin_bit_cast(s16x4, __builtin_amdgcn_ds_read_tr16_b64_v4i16((FA_LAS v4i16_t*)vp));
    const s16x4 hh = __builtin_bit_cast(s16x4, __builtin_amdgcn_ds_read_tr16_b64_v4i16((FA_LAS v4i16_t*)(vp + 512)));
    return (bf16x8){lo[0], lo[1], lo[2], lo[3], hh[0], hh[1], hh[2], hh[3]};
}
__device__ __forceinline__ int row_off(int row, int c8) { return row * 256 + ((c8 ^ (row & 7)) << 4); }
__device__ __forceinline__ float lg2h(int h) { return log2f(1.f - exp2f(-5.f - (float)h)); }
constexpr int QOFF = 0, KOFF = 32768, BOFF = 65536;
__device__ __forceinline__ void stage_rows(FA_LAS unsigned char* dst, const bf16* src, long pitch, int tid) {
#pragma unroll
    for (int i = 0; i < 4; ++i) { const int qd = tid + 512 * i, row = qd >> 4, c8 = qd & 15; *(FA_LAS u32x4*)(dst + row_off(row, c8)) = *(const u32x4*)(src + (long)row * pitch + c8 * 8); }
}
template <int W, bool SCALE> __device__ __forceinline__ void stage_tr(FA_LAS unsigned char* dst, const bf16* src, long pitch, int tid, float lg) {
    constexpr int C8 = W / 8;
#pragma unroll
    for (int i = 0; i < (128 * C8) / 512; ++i) { const int qd = tid + 512 * i, row = qd / C8, c8 = qd % C8; u32x4 v = *(const u32x4*)(src + (long)row * pitch + c8 * 8);
        if (SCALE) { const float f = __builtin_amdgcn_exp2f((float)(127 - row) * lg);
#pragma unroll
            for (int k = 0; k < 4; ++k) { const float a = __builtin_bit_cast(float, v[k] << 16) * f, b2 = __builtin_bit_cast(float, v[k] & 0xffff0000u) * f; v[k] = cvtpk(a, b2); } }
        *(FA_LAS u32x4*)(dst + tr_off(row, c8, 8)) = v; }
}
__device__ __forceinline__ void retU_unit(const Params& q, int u, FA_LAS unsigned char* lds) {
    int tid_ = threadIdx.x; asm volatile("" : "+v"(tid_));
    const int tid = tid_, lane = tid & 63, r32 = lane & 31, hi = lane >> 5, wid = __builtin_amdgcn_readfirstlane(tid >> 6);
    const int n = u % NCH, h = (u / NCH) % RH, b = u / (NCH * RH); const float lg = lg2h(h);
    const long row0 = (long)b * T + n * RC;
    stage_tr<128, true>(lds + QOFF, wsp<bf16>(q, WS_RK) + row0 * 512 + h * RDK, 512, tid, lg);
    stage_tr<256, false>(lds + BOFF, wsp<bf16>(q, WS_RV) + row0 * DM + h * RDV, DM, tid, 0.f);
    __syncthreads();
    const int dkt = wid & 3, dvh = wid >> 2;
    f32x16 acc[4];
#pragma unroll
    for (int t = 0; t < 4; ++t)
#pragma unroll
        for (int r = 0; r < 16; ++r) acc[t][r] = 0.f;
#pragma unroll
    for (int ks = 0; ks < 8; ++ks) { const bf16x8 bk = trfrag(lds + QOFF, 8, dkt, ks, lane, hi);
#pragma unroll
        for (int t = 0; t < 4; ++t) { const bf16x8 av = trfrag(lds + BOFF, 8, 4 * dvh + t, ks, lane, hi); acc[t] = __builtin_amdgcn_mfma_f32_32x32x16_bf16(av, bk, acc[t], 0, 0, 0); } }
    LDS_BAR();
    { FA_LAS unsigned char* ot = lds + (32 * dkt + r32) * 520;
#pragma unroll
      for (int t = 0; t < 4; ++t)
#pragma unroll
          for (int a = 0; a < 4; ++a) { const unsigned w0 = cvtpk(acc[t][4 * a], acc[t][4 * a + 1]), w1 = cvtpk(acc[t][4 * a + 2], acc[t][4 * a + 3]);
              *(FA_LAS unsigned long long*)(ot + (32 * (4 * dvh + t) + 8 * a + 4 * hi) * 2) = (unsigned long long)w0 | ((unsigned long long)w1 << 32); } }
    LDS_BAR();
    { bf16* U = wsp<bf16>(q, WS_RETU) + ((long)(b * RH + h) * NCH + n) * RDK * RDV;
#pragma unroll
      for (int i = 0; i < 8; ++i) { const int qd = tid + 512 * i, row = qd >> 5, c8 = qd & 31; const unsigned long long lo = *(FA_LAS const unsigned long long*)(lds + row * 520 + c8 * 16), hi2 = *(FA_LAS const unsigned long long*)(lds + row * 520 + c8 * 16 + 8);
          *(u32x4*)(U + (long)row * RDV + c8 * 8) = (u32x4){(unsigned)lo, (unsigned)(lo >> 32), (unsigned)hi2, (unsigned)(hi2 >> 32)}; } }
    LDS_BAR();
}
__device__ __forceinline__ void retO_fetch(const Params& q, int u, int tid, u32x4 (&pq)[4], u32x4 (&ps)[8]) {
    const int n = u % NCH, h = (u / NCH) % RH, b = u / (NCH * RH); const long row0 = (long)b * T + n * RC;
    const bf16* qsrc = wsp<bf16>(q, WS_RQ) + row0 * 512 + h * RDK; const bf16* ssrc = wsp<bf16>(q, WS_RETS) + ((long)(b * RH + h) * NCH + n) * RDK * RDV;
#pragma unroll
    for (int i = 0; i < 4; ++i) { const int qd = tid + 512 * i, row = qd >> 4, c8 = qd & 15; pq[i] = *(const u32x4*)(qsrc + (long)row * 512 + c8 * 8); }
#pragma unroll
    for (int i = 0; i < 8; ++i) { const int qd = tid + 512 * i, row = qd >> 5, c8 = qd & 31; ps[i] = *(const u32x4*)(ssrc + (long)row * RDV + c8 * 8); }
}
__device__ __forceinline__ void retO_unit(const Params& q, int l, int u, int unext, u32x4 (&pq)[4], u32x4 (&ps)[8], FA_LAS unsigned char* lds) {
    int tid_ = threadIdx.x; asm volatile("" : "+v"(tid_));
    const int tid = tid_, lane = tid & 63, r32 = lane & 31, hi = lane >> 5, wid = __builtin_amdgcn_readfirstlane(tid >> 6);
    const int n = u % NCH, h = (u / NCH) % RH, b = u / (NCH * RH); const float lg = lg2h(h);
    const long row0 = (long)b * T + n * RC;
#pragma unroll
    for (int i = 0; i < 4; ++i) { const int qd = tid + 512 * i, row = qd >> 4, c8 = qd & 15; *(FA_LAS u32x4*)(lds + QOFF + row_off(row, c8)) = pq[i]; }
#pragma unroll
    for (int i = 0; i < 8; ++i) { const int qd = tid + 512 * i, row = qd >> 5, c8 = qd & 31; *(FA_LAS u32x4*)(lds + BOFF + tr_off(row, c8, 8)) = ps[i]; }
    LDS_BAR();
    const int ct = wid & 3, dh = wid >> 2, c = 32 * ct + r32;
    u32x4 pk_[4], pv_[8];
    { const bf16* ksrc = wsp<bf16>(q, WS_RK) + row0 * 512 + h * RDK; const bf16* vsrc = wsp<bf16>(q, WS_RV) + row0 * DM + h * RDV;
#pragma unroll
      for (int i = 0; i < 4; ++i) { const int qd = tid + 512 * i, row = qd >> 4, c8 = qd & 15; pk_[i] = *(const u32x4*)(ksrc + (long)row * 512 + c8 * 8); }
#pragma unroll
      for (int i = 0; i < 8; ++i) { const int qd = tid + 512 * i, row = qd >> 5, c8 = qd & 31; pv_[i] = *(const u32x4*)(vsrc + (long)row * DM + c8 * 8); } }
    f32x16 acc[4];
#pragma unroll
    for (int t = 0; t < 4; ++t)
#pragma unroll
        for (int r = 0; r < 16; ++r) acc[t][r] = 0.f;
#pragma unroll
    for (int ks = 0; ks < 8; ++ks) {
        const unsigned long long q0 = *(FA_LAS const unsigned long long*)(lds + QOFF + row_off(c, 2 * ks) + 8 * hi), q1 = *(FA_LAS const unsigned long long*)(lds + QOFF + row_off(c, 2 * ks + 1) + 8 * hi);
        const u32x4 qq = (u32x4){(unsigned)q0, (unsigned)(q0 >> 32), (unsigned)q1, (unsigned)(q1 >> 32)}; const bf16x8 bq = __builtin_bit_cast(bf16x8, qq);
#pragma unroll
        for (int t = 0; t < 4; ++t) { const bf16x8 as = trfrag(lds + BOFF, 8, 4 * dh + t, ks, lane, hi); acc[t] = __builtin_amdgcn_mfma_f32_32x32x16_bf16(as, bq, acc[t], 0, 0, 0); } }
    const float qdec = __builtin_amdgcn_exp2f((float)(c + 1) * lg);
#pragma unroll
    for (int t = 0; t < 4; ++t)
#pragma unroll
        for (int r = 0; r < 16; ++r) acc[t][r] *= qdec;
    LDS_BAR();
#pragma unroll
    for (int i = 0; i < 4; ++i) { const int qd = tid + 512 * i, row = qd >> 4, c8 = qd & 15; *(FA_LAS u32x4*)(lds + KOFF + row_off(row, c8)) = pk_[i]; }
#pragma unroll
    for (int i = 0; i < 8; ++i) { const int qd = tid + 512 * i, row = qd >> 5, c8 = qd & 31; *(FA_LAS u32x4*)(lds + BOFF + tr_off(row, c8, 8)) = pv_[i]; }
    LDS_BAR();
    if (unext >= 0) retO_fetch(q, unext, tid, pq, ps);
    bf16x8 qf[8];
#pragma unroll
    for (int ks = 0; ks < 8; ++ks) qf[ks] = *(FA_LAS const bf16x8*)(lds + QOFF + row_off(c, 2 * ks + hi));
#pragma unroll 1
    for (int et = 0; et <= ct; ++et) {
        f32x16 st;
#pragma unroll
        for (int r = 0; r < 16; ++r) st[r] = 0.f;
#pragma unroll
        for (int ks = 0; ks < 8; ++ks) { const bf16x8 kf = *(FA_LAS const bf16x8*)(lds + KOFF + row_off(32 * et + r32, 2 * ks + hi)); st = __builtin_amdgcn_mfma_f32_32x32x16_bf16(kf, qf[ks], st, 0, 0, 0); }
#pragma unroll
        for (int r = 0; r < 16; ++r) { const int ee = 32 * et + crow(r, hi); st[r] = c >= ee ? st[r] * __builtin_amdgcn_exp2f((float)(c - ee) * lg) : 0.f; }
        u32x4 pw[2];
#pragma unroll
        for (int k = 0; k < 4; ++k) { pw[0][k] = cvtpk(st[2 * k], st[2 * k + 1]); pw[1][k] = cvtpk(st[8 + 2 * k], st[9 + 2 * k]); }
#pragma unroll
        for (int ks2 = 0; ks2 < 2; ++ks2)
#pragma unroll
            for (int t = 0; t < 4; ++t) { const bf16x8 av = trfrag(lds + BOFF, 8, 4 * dh + t, 2 * et + ks2, lane, hi); acc[t] = __builtin_amdgcn_mfma_f32_32x32x16_bf16(av, __builtin_bit_cast(bf16x8, pw[ks2]), acc[t], 0, 0, 0); }
    }
    u32x4 sgv[4]; const float* gw = q.in[I_GNW] + l * DM + h * RDV;
#pragma unroll
    for (int i = 0; i < 4; ++i) { const int qd = tid + 512 * i, row = qd >> 5, c8 = qd & 31; sgv[i] = *(const u32x4*)(wsp<bf16>(q, WS_SRG) + (row0 + row) * DM + h * RDV + c8 * 8); }
    float s1 = 0.f, s2 = 0.f;
#pragma unroll
    for (int t = 0; t < 4; ++t)
#pragma unroll
        for (int r = 0; r < 16; ++r) { s1 += acc[t][r]; s2 += acc[t][r] * acc[t][r]; }
    s1 = fa::swapsum(s1); s2 = fa::swapsum(s2);
    FA_LAS float* gst = (FA_LAS float*)(lds + 132096);
    if (hi == 0) { gst[((ct * 2 + dh) * 32 + r32) * 2] = s1; gst[((ct * 2 + dh) * 32 + r32) * 2 + 1] = s2; }
    __syncthreads();
    s1 += gst[((ct * 2 + (1 - dh)) * 32 + r32) * 2]; s2 += gst[((ct * 2 + (1 - dh)) * 32 + r32) * 2 + 1];
    const float mu = s1 * (1.f / RDV), var = fmaxf(s2 * (1.f / RDV) - mu * mu, 0.f), rs = 1.f / sqrtf(var + 1e-5f);
    LDS_BAR();
    { FA_LAS unsigned char* ot = lds + c * 520;
#pragma unroll
      for (int t = 0; t < 4; ++t)
#pragma unroll
          for (int a = 0; a < 4; ++a) { const unsigned w0 = cvtpk((acc[t][4 * a] - mu) * rs, (acc[t][4 * a + 1] - mu) * rs), w1 = cvtpk((acc[t][4 * a + 2] - mu) * rs, (acc[t][4 * a + 3] - mu) * rs);
              *(FA_LAS unsigned long long*)(ot + (32 * (4 * dh + t) + 8 * a + 4 * hi) * 2) = (unsigned long long)w0 | ((unsigned long long)w1 << 32); } }
    LDS_BAR();
    {
#pragma unroll
      for (int i = 0; i < 8; ++i) { const int qd = tid + 512 * i, row = qd >> 5, c8 = qd & 31; const long ro = (row0 + row) * DM + h * RDV + c8 * 8;
          const unsigned long long lo = *(FA_LAS const unsigned long long*)(lds + row * 520 + c8 * 16), hi2 = *(FA_LAS const unsigned long long*)(lds + row * 520 + c8 * 16 + 8);
          const u32x4 nv = (u32x4){(unsigned)lo, (unsigned)(lo >> 32), (unsigned)hi2, (unsigned)(hi2 >> 32)}, sg = i < 4 ? sgv[i < 4 ? i : 0] : *(const u32x4*)(wsp<bf16>(q, WS_SRG) + ro);
          const f32x4 g0 = *(const f32x4*)(gw + c8 * 8), g1 = *(const f32x4*)(gw + c8 * 8 + 4); u32x4 ov;
#pragma unroll
          for (int k = 0; k < 4; ++k) { const float ga = k < 2 ? g0[2 * k] : g1[2 * k - 4], gb = k < 2 ? g0[2 * k + 1] : g1[2 * k - 3];
              ov[k] = cvtpk(__builtin_bit_cast(float, nv[k] << 16) * __builtin_bit_cast(float, sg[k] << 16) * ga, __builtin_bit_cast(float, nv[k] & 0xffff0000u) * __builtin_bit_cast(float, sg[k] & 0xffff0000u) * gb); }
          *(u32x4*)(wsp<bf16>(q, WS_RO) + ro) = ov; } }
    LDS_BAR();
}
}


namespace cp {
using fa::bf16x8; using fa::f32x16; using fa::cvtpk; using fa::crow;
__device__ __forceinline__ void cmp_unit(const Params& q, int l, int u, FA_LAS unsigned char* lds) {
    int tid_ = threadIdx.x; asm volatile("" : "+v"(tid_));
    const int tid = tid_, lane = tid & 63, r32 = lane & 31, hi = lane >> 5, wid = __builtin_amdgcn_readfirstlane(tid >> 6);
    const int e = u & 1, part = u >> 1;
    const int chunk_l = 16 * wid + (r32 >> 1), g = r32 & 1;
    const float* bA; const float* bB; int crow0;
    if (part < NB) { bA = q.out + O_CMPP + (((long)l * NB + part) * T + (long)wid * 256) * 256; bB = bA + 128 * 256; crow0 = part * 128; }
    else { const int sb = (part - NB) >> 2, qt = (part - NB) & 3; const int* pt = (const int*)q.in[I_PT] + sb * NPAGES + qt * 16 + 2 * wid;
        const int pgA = __builtin_amdgcn_readfirstlane(pt[0]), pgB = __builtin_amdgcn_readfirstlane(pt[1]);
        bA = q.in[I_CCMP] + ((long)l * NPHYS + pgA) * PAGE * 256; bB = q.in[I_CCMP] + ((long)l * NPHYS + pgB) * PAGE * 256; crow0 = NB * 128 + sb * 512 + qt * 128; }
    const int lo = hi * 4096 + e * 128 + 4 * r32;
    const bf16* wt = wsp<bf16>(q, WS_W1T) + (size_t)(l * 2 + e) * 128 * 1024;
    FA_LAS unsigned char* stg = lds + 32768 + wid * 4096;
    const int wrow = 2 * hi + (r32 >> 4), wpc = (r32 & 15) >> 1, wofs = (r32 & 1) * 8;
    f32x16 acc[4];
#pragma unroll
    for (int t = 0; t < 4; ++t)
#pragma unroll
        for (int r = 0; r < 16; ++r) acc[t][r] = 0.f;
    u32x4 bn0[2], bn1[2]; f32x4 anA[8], anB[8];
    const int bnr = 16 * wid + (lane >> 3), bc8 = lane & 7;
#define CP_LOADB(bn, s_) do { _Pragma("unroll") for (int i_ = 0; i_ < 2; ++i_) bn[i_] = *(const u32x4*)(wt + (size_t)(bnr + 8 * i_) * 1024 + 64 * (s_) + 8 * bc8); } while (0)
#define CP_STOREB(bn, buf_) do { _Pragma("unroll") for (int i_ = 0; i_ < 2; ++i_) *(FA_LAS u32x4*)(lds + (buf_) * 16384 + bc8 * 2048 + (bnr + 8 * i_) * 16) = bn[i_]; } while (0)
#define CP_LOADA(an, s_) do { _Pragma("unroll") for (int i_ = 0; i_ < 8; ++i_) an[i_] = *(const f32x4*)((i_ < 4 ? bA : bB) + (i_ & 3) * 8192 + (s_) * 256 + lo); } while (0)
#define CP_SLAB(an, bnl, bns, s_) do { bf16x8 af[4]; \
        _Pragma("unroll") for (int i_ = 0; i_ < 8; ++i_) { const int row_ = 4 * i_ + wrow; \
            *(FA_LAS unsigned long long*)(stg + row_ * 128 + ((wpc ^ ((row_ >> 1) & 7)) * 16) + wofs) = (unsigned long long)cvtpk(an[i_][0], an[i_][1]) | ((unsigned long long)cvtpk(an[i_][2], an[i_][3]) << 32); } \
        if ((s_) + 2 < 16) { CP_LOADB(bnl, (s_) + 2); CP_LOADA(an, (s_) + 2); } \
        _Pragma("unroll") for (int k = 0; k < 4; ++k) af[k] = *(FA_LAS const bf16x8*)(stg + r32 * 128 + (((2 * k + hi) ^ ((r32 >> 1) & 7)) * 16)); \
        FA_LAS const unsigned char* bb = lds + ((s_) & 1) * 16384 + hi * 2048 + r32 * 16; \
        _Pragma("unroll") for (int k = 0; k < 4; ++k) _Pragma("unroll") for (int t = 0; t < 4; ++t) { const bf16x8 wf = *(FA_LAS const bf16x8*)(bb + k * 4096 + t * 512); acc[t] = __builtin_amdgcn_mfma_f32_32x32x16_bf16(wf, af[k], acc[t], 0, 0, 0); } \
        if ((s_) + 1 < 16) CP_STOREB(bns, ((s_) + 1) & 1); \
        LDS_BAR(); } while (0)
    CP_LOADB(bn0, 0); CP_LOADA(anA, 0); CP_LOADB(bn1, 1); CP_LOADA(anB, 1); CP_STOREB(bn0, 0);
    __syncthreads();
#pragma unroll 1
    for (int s_ = 0; s_ < 16; s_ += 2) { CP_SLAB(anA, bn0, bn1, s_); CP_SLAB(anB, bn1, bn0, s_ + 1); }
#undef CP_LOADB
#undef CP_STOREB
#undef CP_LOADA
#undef CP_SLAB
    float* P = wsp<float>(q, WS_PCMP) + ((long)(crow0 + chunk_l) * 4 + e * 2 + g) * 128;
#pragma unroll
    for (int t = 0; t < 4; ++t)
#pragma unroll
        for (int a = 0; a < 4; ++a) *(f32x4*)(P + 32 * t + 8 * a + 4 * hi) = (f32x4){acc[t][4 * a], acc[t][4 * a + 1], acc[t][4 * a + 2], acc[t][4 * a + 3]};
}
__device__ __forceinline__ void cmp_fin_wave(const Params& q, int l, int gwave, int ngw, int lane) {
    const int e = gwave & 1; const float* w2 = q.in[I_CW2] + ((long)l * 2 + e) * 64 * 64 + lane; float wc[64];
#pragma unroll
    for (int h = 0; h < 64; ++h) wc[h] = w2[h * 64];
    const float cbv = wsp<float>(q, WS_CB)[(l * 2 + e) * 64 + lane];
    const long nit = (long)CMPROWS * 2, stp = ngw >> 1;
    for (long it = gwave >> 1; it < nit; it += 2 * stp) {
        const long it2 = it + stp; const bool two = it2 < nit;
        const int crA = (int)(it >> 1), gA = (int)it & 1, crB = two ? (int)(it2 >> 1) : crA, gB = two ? (int)it2 & 1 : gA; int nA, nB2;
        const bool vA = cmp_row_valid(crA, nA), vB = cmp_row_valid(crB, nB2);
        const float* PA = wsp<float>(q, WS_PCMP) + ((long)crA * 4 + e * 2 + gA) * 128; const float* PB = wsp<float>(q, WS_PCMP) + ((long)crB * 4 + e * 2 + gB) * 128;
        const float a0 = PA[lane], a1 = PA[512 + 64 + lane], b0 = PB[lane], b1 = PB[512 + 64 + lane];
        const float hidA = vA ? geluf_(cbv + a0 + a1) : 0.f, hidB = vB ? geluf_(cbv + b0 + b1) : 0.f;
        float sA = 0.f, sB = 0.f;
#pragma unroll
        for (int h = 0; h < 64; ++h) { sA += __builtin_bit_cast(float, __builtin_amdgcn_readlane(__builtin_bit_cast(int, hidA), h)) * wc[h]; sB += __builtin_bit_cast(float, __builtin_amdgcn_readlane(__builtin_bit_cast(int, hidB), h)) * wc[h]; }
        wsp<bf16>(q, WS_KC)[(long)crA * 256 + e * 128 + gA * 64 + lane] = (bf16)f2bf(sA);
        if (two) wsp<bf16>(q, WS_KC)[(long)crB * 256 + e * 128 + gB * 64 + lane] = (bf16)f2bf(sB);
    }
}

__device__ __forceinline__ void cmp_fin_mfma(const Params& q, int l, int gwave, int ngw, int lane, int wave, FA_LAS unsigned char* lds) {
    const int e = gwave & 1, r32 = lane & 31, hi = lane >> 5; FA_LAS unsigned char* tile = lds + wave * 4096;
    const float* w2 = q.in[I_CW2] + ((long)l * 2 + e) * 64 * 64;
    bf16x8 bw[4][2];
#pragma unroll
    for (int ks = 0; ks < 4; ++ks)
#pragma unroll
        for (int nt = 0; nt < 2; ++nt) { float t8[8];
#pragma unroll
            for (int k = 0; k < 8; ++k) t8[k] = w2[(16 * ks + 8 * hi + k) * 64 + 32 * nt + r32];
            const u32x4 w = (u32x4){cvtpk(t8[0], t8[1]), cvtpk(t8[2], t8[3]), cvtpk(t8[4], t8[5]), cvtpk(t8[6], t8[7])}; bw[ks][nt] = __builtin_bit_cast(bf16x8, w); }
    const float cbv = wsp<float>(q, WS_CB)[(l * 2 + e) * 64 + lane];
    const long ngroups = (long)CMPROWS * 2 / 32;
    for (long gi = gwave >> 1; gi < ngroups; gi += ngw >> 1) {
        const long it0 = gi * 32; float pa[32], pb[32];
#pragma unroll
        for (int i = 0; i < 32; ++i) { const long it = it0 + i; const int cr = (int)(it >> 1), g = (int)it & 1; int nn; const bool v = cmp_row_valid(cr, nn);
            const float* P = wsp<float>(q, WS_PCMP) + ((long)cr * 4 + e * 2 + g) * 128; pa[i] = v ? P[lane] : 0.f; pb[i] = v ? P[512 + 64 + lane] : 0.f; }
#pragma unroll
        for (int i = 0; i < 32; ++i) { const long it = it0 + i; int nn; const bool v = cmp_row_valid((int)(it >> 1), nn);
            *(FA_LAS bf16*)(tile + (i * 64 + lane) * 2) = v ? (bf16)f2bf(geluf_(cbv + pa[i] + pb[i])) : (bf16)0; }
        f32x16 acc[2];
#pragma unroll
        for (int r = 0; r < 16; ++r) { acc[0][r] = 0.f; acc[1][r] = 0.f; }
#pragma unroll
        for (int ks = 0; ks < 4; ++ks) { const bf16x8 af = *(FA_LAS const bf16x8*)(tile + (r32 * 64 + 16 * ks + 8 * hi) * 2);
#pragma unroll
            for (int nt = 0; nt < 2; ++nt) acc[nt] = __builtin_amdgcn_mfma_f32_32x32x16_bf16(af, bw[ks][nt], acc[nt], 0, 0, 0); }
#pragma unroll
        for (int r = 0; r < 16; ++r) { const long it = it0 + crow(r, hi); const int cr = (int)(it >> 1), g = (int)it & 1; bf16* kc = wsp<bf16>(q, WS_KC) + (long)cr * 256 + e * 128 + g * 64 + r32;
            kc[0] = (bf16)f2bf(acc[0][r]); kc[32] = (bf16)f2bf(acc[1][r]); }
    }
}
static_assert(((long)CMPROWS * 2) % 32 == 0, "compress finalize groups");
}


namespace sa {
using fa::bf16x8; using fa::f32x16; using fa::cvtpk; using fa::crow; using fa::swapmax; using fa::swapsum; using fa::partner; using fa::qkt; using fa::pvt; using fa::MASKV; using fa::MINIT;
constexpr int EX = 132096, EX_STATS = EX, EX_EB = EX + 2048, EX_IMP = EX + 3072, EX_SEL = EX + 5248, EX_UL = EX + 5888, EX_UC = EX + 6416;
static_assert(EX_UC + 16 <= 147456, "LDS extra region");
__device__ __forceinline__ const char* uniform_ptr(const void* p) { const unsigned long long u = (unsigned long long)p;
    return (const char*)(((unsigned long long)(unsigned)__builtin_amdgcn_readfirstlane((int)(u >> 32)) << 32) | (unsigned)__builtin_amdgcn_readfirstlane((int)u)); }
__device__ __forceinline__ void wtile_bf16(FA_LAS unsigned char* slot, const bf16* base, int lane) {
    asm volatile("" : "+v"(lane));
    const int rsub = lane >> 3, c8 = lane & 7; const unsigned voff = (unsigned)(rsub * 256 + 8 * c8) * 2u; const char* ub = uniform_ptr(base);
    u32x4 kr[8], vr[8];
#pragma unroll
    for (int j = 0; j < 8; ++j) { kr[j] = *(const u32x4*)(ub + j * 4096 + voff); vr[j] = *(const u32x4*)(ub + 256 + j * 4096 + voff); }
    FA_LAS unsigned char* kd = slot + c8 * 1024; FA_LAS unsigned char* vd = slot + 8192 + (c8 >> 2) * 4096 + (c8 & 3) * 16;
#pragma unroll
    for (int j = 0; j < 8; ++j) { const int row = 8 * j + rsub; *(FA_LAS u32x4*)(kd + ((row ^ c8) * 16)) = kr[j]; }
#pragma unroll
    for (int j = 0; j < 8; ++j) { const int row = 8 * j + rsub; *(FA_LAS u32x4*)(vd + (row >> 4) * 1024 + (row & 15) * 64) = vr[j]; }
}
__device__ __forceinline__ void wtile_f32(FA_LAS unsigned char* slot, const float* base, int lane) {
    asm volatile("" : "+v"(lane));
    const int rsub = lane >> 4, c4 = lane & 15, c8 = c4 >> 1, hb = (c4 & 1) * 8; const unsigned voff = (unsigned)(rsub * 256 + 4 * c4) * 4u; const char* ub = uniform_ptr(base);
    f32x4 kr[16], vr[4];
#pragma unroll
    for (int j = 0; j < 16; ++j) kr[j] = *(const f32x4*)(ub + j * 4096 + voff);
#pragma unroll
    for (int j = 0; j < 4; ++j) vr[j] = *(const f32x4*)(ub + 512 + j * 4096 + voff);
    FA_LAS unsigned char* kd = slot + c8 * 1024 + hb; FA_LAS unsigned char* vd = slot + 8192 + (c8 >> 2) * 4096 + (c8 & 3) * 16 + hb;
#pragma unroll
    for (int j = 0; j < 16; ++j) { const int row = 4 * j + rsub; *(FA_LAS unsigned long long*)(kd + ((row ^ c8) * 16)) = (unsigned long long)cvtpk(kr[j][0], kr[j][1]) | ((unsigned long long)cvtpk(kr[j][2], kr[j][3]) << 32); }
#pragma unroll
    for (int j = 0; j < 12; ++j) kr[j] = *(const f32x4*)(ub + 512 + (4 + j) * 4096 + voff);
#pragma unroll
    for (int j = 0; j < 4; ++j) { const int row = 4 * j + rsub; *(FA_LAS unsigned long long*)(vd + (row >> 4) * 1024 + (row & 15) * 64) = (unsigned long long)cvtpk(vr[j][0], vr[j][1]) | ((unsigned long long)cvtpk(vr[j][2], vr[j][3]) << 32); }
#pragma unroll
    for (int j = 0; j < 12; ++j) { const int row = 4 * (4 + j) + rsub; *(FA_LAS unsigned long long*)(vd + (row >> 4) * 1024 + (row & 15) * 64) = (unsigned long long)cvtpk(kr[j][0], kr[j][1]) | ((unsigned long long)cvtpk(kr[j][2], kr[j][3]) << 32); }
}
__device__ __forceinline__ void qkt_sw(f32x16& p0, f32x16& p1, FA_LAS const unsigned char* kslot, const bf16x8* qr, int r32, int hi) {
#pragma unroll
    for (int r = 0; r < 16; ++r) { p0[r] = 0.f; p1[r] = 0.f; }
#pragma unroll
    for (int d0 = 0; d0 < 4; ++d0) { const int c8 = 2 * d0 + hi; FA_LAS const unsigned char* kb = kslot + c8 * 1024 + ((r32 ^ c8) * 16);
        const bf16x8 b0 = *(FA_LAS const bf16x8*)kb, b1 = *(FA_LAS const bf16x8*)(kb + 512);
        p0 = __builtin_amdgcn_mfma_f32_32x32x16_bf16(b0, qr[d0], p0, 0, 0, 0);
        p1 = __builtin_amdgcn_mfma_f32_32x32x16_bf16(b1, qr[d0], p1, 0, 0, 0);
    }
}
__device__ __forceinline__ void wstep(FA_LAS const unsigned char* slot, const bf16x8* qr, int lane, int r32, int hi, bool lanesel, int mode, int ts, float& mrun, float& lrun, f32x16* o) {
    f32x16 p0, p1; qkt_sw(p0, p1, slot, qr, r32, hi);
    if (mode == 1) {
#pragma unroll
        for (int r = 0; r < 16; ++r) { const int key = crow(r, hi); if (key > ts) p0[r] = MASKV; p1[r] = MASKV; } }
    if (mode == 2) {
#pragma unroll
        for (int r = 0; r < 16; ++r) { const int key = crow(r, hi); if (key <= ts) p0[r] = MASKV; } }
    float mt = fmaxf(p0[0], p1[0]);
#pragma unroll
    for (int r = 1; r < 16; ++r) mt = fmaxf(mt, fmaxf(p0[r], p1[r]));
    mt = swapmax(mt); if (!lanesel) mt = MASKV;
    const float mnew = fmaxf(mrun, mt), alpha = __builtin_amdgcn_exp2f(mrun - mnew);
    mrun = mnew; lrun *= alpha;
#pragma unroll
    for (int r = 0; r < 16; ++r) { o[0][r] *= alpha; o[1][r] *= alpha; }
    float ls = 0.f;
#pragma unroll
    for (int r = 0; r < 16; ++r) { float a = __builtin_amdgcn_exp2f(p0[r] - mnew), c = __builtin_amdgcn_exp2f(p1[r] - mnew); if (!lanesel) { a = 0.f; c = 0.f; } p0[r] = a; p1[r] = c; ls += a + c; }
    lrun += ls;
    pvt(o, slot + 8192, lane, hi, p0, p1);
}
__device__ __forceinline__ float wave_factor(FA_LAS unsigned char* lds, int wid, int r32, int hi, float mrun, float lrun) {
    FA_LAS float* st = (FA_LAS float*)(lds + EX_STATS);
    const float lt = swapsum(lrun);
    __syncthreads();
    if (hi == 0) { st[(wid * 32 + r32) * 2] = mrun; st[(wid * 32 + r32) * 2 + 1] = lt; }
    __syncthreads();
    float M = MINIT;
#pragma unroll
    for (int w = 0; w < 8; ++w) M = fmaxf(M, st[(w * 32 + r32) * 2]);
    float L = 0.f;
#pragma unroll
    for (int w = 0; w < 8; ++w) L += st[(w * 32 + r32) * 2 + 1] * __builtin_amdgcn_exp2f(st[(w * 32 + r32) * 2] - M);
    return L > 0.f ? __builtin_amdgcn_exp2f(mrun - M) / L : 0.f;
}
__device__ __forceinline__ void attn_sample_unit(const Params& q, int l, int sb, int g, FA_LAS unsigned char* lds) {
    int tid_ = threadIdx.x; asm volatile("" : "+v"(tid_));
    const int tid = tid_, lane = tid & 63, r32 = lane & 31, hi = lane >> 5, wid = __builtin_amdgcn_readfirstlane(tid >> 6);
    const int ts = (r32 & 15) >> 2, hq = r32 & 3, head = 4 * g + hq;
    const long m = (long)BT + sb * DS + ts;
    const bf16* qp = wsp<bf16>(q, WS_QB) + m * 512 + head * 64;
    bf16x8 qr[4];
#pragma unroll
    for (int d0 = 0; d0 < 4; ++d0) qr[d0] = *(const bf16x8*)(qp + 16 * d0 + 8 * hi);
    const float* agp = wsp<float>(q, WS_AG) + m * 32 + head * 3;
    const float gc = agp[0], gs = agp[1], gw = agp[2];
    FA_LAS unsigned char* slot = lds + wid * 16384;
    FA_LAS float* impb = (FA_LAS float*)(lds + EX_IMP); FA_LAS unsigned char* selb = lds + EX_SEL; FA_LAS int* ulist = (FA_LAS int*)(lds + EX_UL); FA_LAS int* ucnt = (FA_LAS int*)(lds + EX_UC);
    f32x16 res[2], o[2];
#pragma unroll
    for (int r = 0; r < 16; ++r) { res[0][r] = 0.f; res[1][r] = 0.f; o[0][r] = 0.f; o[1][r] = 0.f; }
    {
        wtile_bf16(slot, wsp<bf16>(q, WS_KC) + (long)(NB * 128 + sb * 512 + 64 * wid) * 256 + g * 64, lane);
        f32x16 p0, p1; qkt_sw(p0, p1, slot, qr, r32, hi);
        if (wid == 7 && hi == 1) p1[15] = MASKV;
        float mt = fmaxf(p0[0], p1[0]);
#pragma unroll
        for (int r = 1; r < 16; ++r) mt = fmaxf(mt, fmaxf(p0[r], p1[r]));
        const float mw = swapmax(mt); float ls = 0.f;
#pragma unroll
        for (int r = 0; r < 16; ++r) { p0[r] = __builtin_amdgcn_exp2f(p0[r] - mw); p1[r] = __builtin_amdgcn_exp2f(p1[r] - mw); ls += p0[r] + p1[r]; }
        const float f = wave_factor(lds, wid, r32, hi, mw, ls);
        float G[8], E[8];
#pragma unroll
        for (int a = 0; a < 4; ++a) { G[a] = ((p0[4 * a] + p0[4 * a + 1]) + (p0[4 * a + 2] + p0[4 * a + 3])) * f; E[a] = p0[4 * a + 3] * f; G[4 + a] = ((p1[4 * a] + p1[4 * a + 1]) + (p1[4 * a + 2] + p1[4 * a + 3])) * f; E[4 + a] = p1[4 * a + 3] * f; }
        FA_LAS float* eb = (FA_LAS float*)(lds + EX_EB);
        if (hi == 1) eb[wid * 32 + r32] = E[7];
        float Ep[8];
#pragma unroll
        for (int k = 0; k < 8; ++k) Ep[k] = partner(E[k], hi);
        __syncthreads();
        const float eprev = wid > 0 ? eb[(wid > 0 ? wid - 1 : 0) * 32 + r32] : 0.f;
#pragma unroll
        for (int k = 0; k < 8; ++k) { const float add = hi ? Ep[k] : (k > 0 ? Ep[k > 0 ? k - 1 : 0] : eprev); G[k] += add; }
#pragma unroll
        for (int k = 0; k < 8; ++k) { G[k] += __shfl_xor(G[k], 1); G[k] += __shfl_xor(G[k], 2); }
        if (hq == 0 && r32 < 16) {
#pragma unroll
            for (int k = 0; k < 8; ++k) impb[ts * 132 + 16 * wid + 8 * (k >> 2) + 2 * (k & 3) + hi] = G[k]; }
        pvt(o, slot + 8192, lane, hi, p0, p1);
        const float sc = gc * f;
#pragma unroll
        for (int r = 0; r < 16; ++r) { res[0][r] += o[0][r] * sc; res[1][r] += o[1][r] * sc; o[0][r] = 0.f; o[1][r] = 0.f; }
    }
    __syncthreads();
    { const int tk = tid >> 7, j = tid & 127; bool sel = (j == 0) || (j == 127);
      if (j >= 1 && j <= 126) { const float v = impb[tk * 132 + j]; int rank = 0;
          for (int jj = 1; jj <= 126; ++jj) { const float t = impb[tk * 132 + jj]; rank += (t > v || (t == v && jj < j)) ? 1 : 0; }
          sel = rank < 13; }
      selb[tk * 132 + j] = sel ? 1 : 0; if (j == 0) selb[tk * 132 + 128] = 1; }
    __syncthreads();
    if (wid == 0) {
        int cnt = 0;
#pragma unroll 1
        for (int base = 0; base < 192; base += 64) { const int j = base + lane; const bool any = j <= 128 && (selb[j] | selb[132 + j] | selb[264 + j] | selb[396 + j]);
            const unsigned long long bal = __ballot(any); const int pos = cnt + __builtin_popcountll(bal & ((1ull << lane) - 1ull)); if (any) ulist[pos] = j; cnt += __builtin_popcountll(bal); }
        if (lane == 0) *ucnt = cnt; }
    __syncthreads();
    float mrun = MINIT, lrun = 0.f;
    { const int nU = *ucnt; const int* pt = (const int*)q.in[I_PT] + sb * NPAGES;
#pragma unroll 1
      for (int it = wid; it < nU; it += 8) { const int j = ulist[it]; const bool lanesel = selb[ts * 132 + j] != 0;
          if (j < 128) { const int pg = pt[j >> 1]; wtile_f32(slot, q.in[I_CSEL] + (((long)l * NPHYS + pg) * PAGE + (j & 1) * 64) * 256 + g * 64, lane); wstep(slot, qr, lane, r32, hi, lanesel, 0, ts, mrun, lrun, o); }
          else { wtile_bf16(slot, wsp<bf16>(q, WS_KVS) + ((long)BT + sb * DS) * 256 + g * 64, lane); wstep(slot, qr, lane, r32, hi, lanesel, 1, ts, mrun, lrun, o); } } }
    { const float f = wave_factor(lds, wid, r32, hi, mrun, lrun), sc = gs * f;
#pragma unroll
      for (int r = 0; r < 16; ++r) { res[0][r] += o[0][r] * sc; res[1][r] += o[1][r] * sc; o[0][r] = 0.f; o[1][r] = 0.f; } }
    mrun = MINIT; lrun = 0.f;
    { wtile_f32(slot, q.in[I_SWIN] + (((long)l * DB + sb) * 512 + 64 * wid) * 256 + g * 64, lane); wstep(slot, qr, lane, r32, hi, true, wid == 0 ? 2 : 0, ts, mrun, lrun, o);
      if (wid == 0) { wtile_bf16(slot, wsp<bf16>(q, WS_KVW) + ((long)BT + sb * DS) * 256 + g * 64, lane); wstep(slot, qr, lane, r32, hi, true, 1, ts, mrun, lrun, o); } }
    { const float f = wave_factor(lds, wid, r32, hi, mrun, lrun), sc = gw * f;
#pragma unroll
      for (int r = 0; r < 16; ++r) { res[0][r] += o[0][r] * sc; res[1][r] += o[1][r] * sc; } }
    __syncthreads();
    { FA_LAS float* rs = (FA_LAS float*)slot;
      if (r32 < 16) {
#pragma unroll
          for (int d0 = 0; d0 < 2; ++d0)
#pragma unroll
              for (int a = 0; a < 4; ++a) *(FA_LAS f32x4*)(rs + r32 * 64 + 32 * d0 + 8 * a + 4 * hi) = (f32x4){res[d0][4 * a], res[d0][4 * a + 1], res[d0][4 * a + 2], res[d0][4 * a + 3]}; } }
    __syncthreads();
    { const int row = tid >> 5, d2 = (tid & 31) * 2; float s0 = 0.f, s1 = 0.f;
#pragma unroll
      for (int w = 0; w < 8; ++w) { const FA_LAS float* rs = (const FA_LAS float*)(lds + w * 16384); s0 += rs[row * 64 + d2]; s1 += rs[row * 64 + d2 + 1]; }
      const long mo = (long)BT + sb * DS + (row >> 2);
      *(unsigned*)(wsp<bf16>(q, WS_OA) + mo * 512 + (4 * g + (row & 3)) * 64 + d2) = cvtpk(s0, s1); }
    __syncthreads();
}
}


namespace sk {
using fa::bf16x8; using fa::f32x16; using fa::crow; using fa::cvtpk;
static_assert(NS % 32 == 0 && NS / 32 * 32 <= 256, "sample rows in 32-row tiles");
constexpr int NT = (NS / 32) * (DM / 32);
__device__ __forceinline__ f32x16 wave_part(const bf16* A, const bf16* Bt, int K, int row0, int col0, int wid, int r32, int hi) {
    f32x16 acc;
#pragma unroll
    for (int r = 0; r < 16; ++r) acc[r] = 0.f;
    const int kw = K / 8; const bf16* ap = A + (long)(row0 + r32) * K + wid * kw + 8 * hi; const bf16* bp = Bt + (long)(col0 + r32) * K + wid * kw + 8 * hi;
    const int nks = kw / 16;
#pragma unroll 1
    for (int k0 = 0; k0 < nks; k0 += 8) { bf16x8 a[8], b[8];
#pragma unroll
        for (int j = 0; j < 8; ++j) { const int ks = k0 + j < nks ? k0 + j : nks - 1; a[j] = *(const bf16x8*)(ap + 16 * ks); b[j] = *(const bf16x8*)(bp + 16 * ks); }
#pragma unroll
        for (int j = 0; j < 8; ++j) if (k0 + j < nks) acc = __builtin_amdgcn_mfma_f32_32x32x16_bf16(a[j], b[j], acc, 0, 0, 0); }
    return acc;
}
__device__ __forceinline__ void put_part(FA_LAS float* part, const f32x16& acc, int wid, int r32, int hi) {
#pragma unroll
    for (int r = 0; r < 16; ++r) part[(wid * 32 + crow(r, hi)) * 32 + r32] = acc[r];
}
__device__ __forceinline__ void mix_tile(const Params& q, int l, int tile, FA_LAS unsigned char* lds) {
    int tid_ = threadIdx.x; asm volatile("" : "+v"(tid_));
    const int tid = tid_, lane = tid & 63, r32 = lane & 31, hi = lane >> 5, wid = __builtin_amdgcn_readfirstlane(tid >> 6);
    const int row0 = BT + 32 * (tile / (DM / 32)), col0 = 32 * (tile % (DM / 32));
    const long o = (long)(row0 + (tid >> 4)) * DM + col0 + (tid & 15) * 2; const unsigned ga = *(const unsigned*)(wsp<bf16>(q, WS_SGA) + o), gb = *(const unsigned*)(wsp<bf16>(q, WS_SGB) + o);
    const f32x16 pa = wave_part(wsp<bf16>(q, WS_OA), wsp<bf16>(q, WS_WTOA) + (size_t)l * DM * 512, 512, row0, col0, wid, r32, hi);
    const f32x16 pb = wave_part(wsp<bf16>(q, WS_RO), wsp<bf16>(q, WS_WTOB) + (size_t)l * DM * DM, DM, row0, col0, wid, r32, hi);
    FA_LAS float* PA = (FA_LAS float*)lds; FA_LAS float* PB = (FA_LAS float*)(lds + 32768);
    put_part(PA, pa, wid, r32, hi); put_part(PB, pb, wid, r32, hi);
    __syncthreads();
    { const int row = tid >> 4, c2 = (tid & 15) * 2; float a0 = 0.f, a1 = 0.f, b0 = 0.f, b1 = 0.f;
#pragma unroll
      for (int w = 0; w < 8; ++w) { a0 += PA[(w * 32 + row) * 32 + c2]; a1 += PA[(w * 32 + row) * 32 + c2 + 1]; b0 += PB[(w * 32 + row) * 32 + c2]; b1 += PB[(w * 32 + row) * 32 + c2 + 1]; }
      const float r0 = __builtin_bit_cast(float, ga << 16) * a0 + __builtin_bit_cast(float, gb << 16) * b0, r1 = __builtin_bit_cast(float, ga & 0xffff0000u) * a1 + __builtin_bit_cast(float, gb & 0xffff0000u) * b1;
      *(unsigned*)(wsp<bf16>(q, WS_MIX) + o) = cvtpk(r0, r1); }
    __syncthreads();
}
__device__ __forceinline__ void resid_tile(const Params& q, int l, const bf16* A, const bf16* Bt, int K, int goff, int nkind, int xin, int tile, FA_LAS unsigned char* lds) {
    int tid_ = threadIdx.x; asm volatile("" : "+v"(tid_));
    const int tid = tid_, lane = tid & 63, r32 = lane & 31, hi = lane >> 5, wid = __builtin_amdgcn_readfirstlane(tid >> 6);
    const int row0 = BT + 32 * (tile / (DM / 32)), col0 = 32 * (tile % (DM / 32));
    const int m = row0 + (tid >> 4), col = col0 + (tid & 15) * 2; const RowInfo ri = rowinfo(m); const float* g = wsp<float>(q, WS_MOD) + ((long)l * NMODROW + ri.modrow) * 6144 + goff + col; float* x = wsp<float>(q, WS_X) + (long)m * DM + col;
    const float* xs = xin ? q.in[I_XS] + (long)(m - BT) * DM + col : x;
    const float g0 = g[0], g1 = g[1], x0 = xs[0], x1 = xs[1];
    const f32x16 pa = wave_part(A, Bt, K, row0, col0, wid, r32, hi);
    FA_LAS float* PA = (FA_LAS float*)lds;
    put_part(PA, pa, wid, r32, hi);
    __syncthreads();
    { const int row = tid >> 4, c2 = (tid & 15) * 2; float a0 = 0.f, a1 = 0.f;
#pragma unroll
      for (int w = 0; w < 8; ++w) { a0 += PA[(w * 32 + row) * 32 + c2]; a1 += PA[(w * 32 + row) * 32 + c2 + 1]; }
      const float y0 = x0 + g0 * a0, y1 = x1 + g1 * a1; x[0] = y0; x[1] = y1;
      if (nkind >= 0) { const float* nw = fuse_nw(q, l, nkind) + col; const float* sc = fuse_sc(q, l, nkind, ri.modrow) + col;
          *(unsigned*)(wsp<bf16>(q, WS_XN) + (long)m * DM + col) = cvtpk(y0 * nw[0] * (1.f + sc[0]), y1 * nw[1] * (1.f + sc[1]));
          float ssq = y0 * y0 + y1 * y1; ssq += __shfl_xor(ssq, 1); ssq += __shfl_xor(ssq, 2); ssq += __shfl_xor(ssq, 4); ssq += __shfl_xor(ssq, 8);
          if ((tid & 15) == 0) wsp<float>(q, WS_SSP)[(long)m * 32 + (tile % (DM / 32))] = ssq; } }
    __syncthreads();
}
__device__ __forceinline__ void shp_task(const Params& q, int task, int lane) {
    const int r32 = lane & 31, hi = lane >> 5;
    constexpr int CT_F = NFI / 32, CT_I = NINP / 32; int which, rem = task;
    if (rem < 2 * CT_F) which = 0; else if (rem < 4 * CT_F) { which = 1; rem -= 2 * CT_F; } else { which = 2; rem -= 4 * CT_F; }
    const int nct = which == 2 ? CT_I : CT_F, rt = rem / nct, col0 = 32 * (rem % nct);
    const int r = 32 * rt + r32; const bool rv = r < NMODROW;
    const float* sh = which == 2 ? wsp<float>(q, WS_MOD) + ((long)1 * NMODROW + (rv ? r : 0)) * 6144 : wsp<float>(q, WS_MOD) + ((long)which * NMODROW + (rv ? r : 0)) * 6144 + 3072;
    const bf16* w = (which == 2 ? wsp<bf16>(q, WS_WTIN) + (size_t)1 * NINP * DM : wsp<bf16>(q, WS_WTFI) + (size_t)which * NFI * DM) + (size_t)(col0 + r32) * DM + 8 * hi;
    f32x16 acc;
#pragma unroll
    for (int k = 0; k < 16; ++k) acc[k] = 0.f;
#pragma unroll 8
    for (int ks = 0; ks < DM / 16; ++ks) { const f32x4 s0 = *(const f32x4*)(sh + 16 * ks + 8 * hi), s1 = *(const f32x4*)(sh + 16 * ks + 8 * hi + 4);
        u32x4 aw = (u32x4){cvtpk(s0[0], s0[1]), cvtpk(s0[2], s0[3]), cvtpk(s1[0], s1[1]), cvtpk(s1[2], s1[3])}; if (!rv) aw = (u32x4){0u, 0u, 0u, 0u};
        acc = __builtin_amdgcn_mfma_f32_32x32x16_bf16(__builtin_bit_cast(bf16x8, aw), *(const bf16x8*)(w + 16 * ks), acc, 0, 0, 0); }
#pragma unroll
    for (int k = 0; k < 16; ++k) { const int rr = 32 * rt + crow(k, hi); if (rr < NMODROW) wsp<float>(q, WS_SHP)[((long)which * 64 + rr) * NINP + col0 + r32] = acc[k]; }
}
constexpr int SHP_TASKS = 2 * (2 * (NFI / 32) + NINP / 32);
}

#define GASP __attribute__((address_space(1)))
__device__ __forceinline__ float wave_sum(float v) {
#pragma unroll
    for (int o = 1; o < 64; o <<= 1) v += __shfl_xor(v, o);
    return v;
}
__device__ __forceinline__ const float* norm_src(const Params& p, int l, int which, int m, const RowInfo& ri) {
    if (which == 0 && l == 0) return ri.kind == 0 ? p.in[I_XP] + (long)m * DM : p.in[I_XS] + (long)(m - BT) * DM;
    return wsp<float>(p, WS_X) + (long)m * DM; }
__device__ __forceinline__ void norm_finish(const Params& p, int l, int which, int m, const RowInfo& ri, const f32x4 (&v)[4], float ss, int lane) {
    bf16* xn = wsp<bf16>(p, WS_XN) + (long)m * DM; float* X = wsp<float>(p, WS_X) + (long)m * DM;
    const float rs = 1.f / sqrtf(wave_sum(ss) * (1.f / DM) + 1e-6f);
    if (which == 2) { float* y = ri.kind == 0 ? p.out + O_YP + (long)m * DM : p.out + O_YS + (long)(m - BT) * DM; const float* w = p.in[I_NFW];
#pragma unroll
        for (int j = 0; j < 4; ++j) { const f32x4 wv = *(const f32x4*)(w + 256 * j + 4 * lane); *(f32x4*)(y + 256 * j + 4 * lane) = v[j] * rs * wv; }
        return; }
    const float* w = (which == 0 ? p.in[I_N1W] : p.in[I_N2W]) + l * DM; const float* mod = wsp<float>(p, WS_MOD) + ((long)l * NMODROW + ri.modrow) * 6144 + (which == 0 ? 0 : 3072);
#pragma unroll
    for (int j = 0; j < 4; ++j) { const int c = 256 * j + 4 * lane; const f32x4 wv = *(const f32x4*)(w + c), sh = *(const f32x4*)(mod + c), sc = *(const f32x4*)(mod + 1024 + c);
        const f32x4 h = v[j] * rs * wv * (sc + 1.f) + sh;
        *(unsigned long long*)(xn + c) = (unsigned long long)pk2(h[0], h[1]) | ((unsigned long long)pk2(h[2], h[3]) << 32);
        (void)X; }
}
template <int NR> __device__ __forceinline__ void fast_norm_rows(const Params& p, int l, int which, int grp, int lane) {
    f32x4 v[NR][4]; RowInfo ri[NR];
#pragma unroll
    for (int k = 0; k < NR; ++k) { const int m = NR * grp + k; ri[k] = rowinfo(m < MP ? m : MP - 1); if (m >= MP) ri[k].kind = 3;
        if (ri[k].kind < 2) { const float* src = norm_src(p, l, which, m, ri[k]);
#pragma unroll
            for (int j = 0; j < 4; ++j) v[k][j] = *(const f32x4*)(src + 256 * j + 4 * lane); } }
#pragma unroll
    for (int k = 0; k < NR; ++k) { const int m = NR * grp + k;
        if (ri[k].kind < 2) { float ss = 0.f;
#pragma unroll
            for (int j = 0; j < 4; ++j) ss += (v[k][j][0] * v[k][j][0] + v[k][j][1] * v[k][j][1]) + (v[k][j][2] * v[k][j][2] + v[k][j][3] * v[k][j][3]);
            norm_finish(p, l, which, m, ri[k], v[k], ss, lane); }
        else if (ri[k].kind == 2 && which != 2) {
#pragma unroll
            for (int j = 0; j < 4; ++j) *(unsigned long long*)(wsp<bf16>(p, WS_XN) + (long)m * DM + 256 * j + 4 * lane) = 0ull; } }
}
constexpr int NORM_NR = 5;

__device__ __forceinline__ void fast_gn_row(const Params& p, int l, long item, int lane) {
    const long m = item / RH; const int h = (int)(item % RH); const long off = m * DM + h * RDV + 4 * lane;
    const f32x4 o = *(const f32x4*)(wsp<float>(p, WS_ORAW) + off);
    const float mu = wave_sum((o[0] + o[1]) + (o[2] + o[3])) * (1.f / RDV); const f32x4 d = o - mu;
    const float var = wave_sum((d[0] * d[0] + d[1] * d[1]) + (d[2] * d[2] + d[3] * d[3])) * (1.f / RDV); const float rs = 1.f / sqrtf(var + 1e-5f);
    const f32x4 w = *(const f32x4*)(p.in[I_GNW] + l * DM + h * RDV + 4 * lane); const unsigned long long sg = *(const unsigned long long*)(wsp<bf16>(p, WS_SRG) + off);
    const float r0 = bf2f((bf16)(sg & 0xffff)) * d[0] * rs * w[0], r1 = bf2f((bf16)((sg >> 16) & 0xffff)) * d[1] * rs * w[1], r2 = bf2f((bf16)((sg >> 32) & 0xffff)) * d[2] * rs * w[2], r3 = bf2f((bf16)(sg >> 48)) * d[3] * rs * w[3];
    *(unsigned long long*)(wsp<bf16>(p, WS_RO) + off) = (unsigned long long)pk2(r0, r1) | ((unsigned long long)pk2(r2, r3) << 32);
}
__device__ __forceinline__ void fast_wt_item(const float* W, int K, int Nsrc, bf16* WT, int k0, int n0, int sc, LAS float* scr, int lane) {
    float tv[32];
#pragma unroll
    for (int i = 0; i < 32; ++i) { const int kk = 2 * i + (lane >> 5); tv[i] = sc >= 0 ? W[(size_t)(k0 + kk) * Nsrc + sc] : 0.f; }
#pragma unroll
    for (int i = 0; i < 32; ++i) { const int kk = 2 * i + (lane >> 5); scr[kk * 33 + (lane & 31)] = tv[i]; }
    asm volatile("s_waitcnt lgkmcnt(0)" ::: "memory");
    const int c = lane & 7;
#pragma unroll
    for (int j = 0; j < 4; ++j) { const int n = (lane >> 3) + 8 * j; const LAS float* s = scr + (8 * c) * 33 + n;
        u32x4 o; o.x = pk2(s[0 * 33], s[1 * 33]); o.y = pk2(s[2 * 33], s[3 * 33]); o.z = pk2(s[4 * 33], s[5 * 33]); o.w = pk2(s[6 * 33], s[7 * 33]);
        *(u32x4*)(WT + (size_t)(n0 + n) * K + k0 + 8 * c) = o; }
    asm volatile("s_waitcnt lgkmcnt(0)" ::: "memory");
}
__device__ __forceinline__ void fast_prologue_weights(const Params& p, LAS unsigned char* lds, int gw, int ngw, int wave, int lane) {
    LAS float* scr = (LAS float*)(lds + wave * 16384);
    constexpr int I_IN = (DM / 64) * (NINP / 32), I_FI = (DM / 64) * (NFI / 32), I_OA = (512 / 64) * (DM / 32), I_OB = (DM / 64) * (DM / 32), I_O = I_OB, I_FO = (DFF / 64) * (DM / 32);
    constexpr int I_W1 = 4 * (1024 / 64) * (64 / 32);
    constexpr int PER_L = I_IN + I_FI + I_OA + I_OB + I_O + I_FO + I_W1;
    for (int it = gw; it < 2 * PER_L; it += ngw) {
        const int l = it / PER_L; int r = it % PER_L;
        if (r < I_IN) { const int nb = NINP / 32, kb = r / nb, n0 = 32 * (r % nb); fast_wt_item(p.in[I_WIN] + (size_t)l * DM * N_IN, DM, N_IN, wsp<bf16>(p, WS_WTIN) + (size_t)l * NINP * DM, 64 * kb, n0, win_srccol(n0 + (lane & 31)), scr, lane); continue; } r -= I_IN;
        if (r < I_FI) { const int nb = NFI / 32, kb = r / nb, n0 = 32 * (r % nb), n = n0 + (lane & 31); const int sc = ((n % 256) / 128) * DFF + (n / 256) * 128 + (n % 128);
            fast_wt_item(p.in[I_FWI] + (size_t)l * DM * NFI, DM, NFI, wsp<bf16>(p, WS_WTFI) + (size_t)l * NFI * DM, 64 * kb, n0, sc, scr, lane); continue; } r -= I_FI;
        if (r < I_OA) { const int nb = DM / 32, kb = r / nb, n0 = 32 * (r % nb); fast_wt_item(p.in[I_WOA] + (size_t)l * 512 * DM, 512, DM, wsp<bf16>(p, WS_WTOA) + (size_t)l * DM * 512, 64 * kb, n0, n0 + (lane & 31), scr, lane); continue; } r -= I_OA;
        if (r < I_OB) { const int nb = DM / 32, kb = r / nb, n0 = 32 * (r % nb); fast_wt_item(p.in[I_WOB] + (size_t)l * DM * DM, DM, DM, wsp<bf16>(p, WS_WTOB) + (size_t)l * DM * DM, 64 * kb, n0, n0 + (lane & 31), scr, lane); continue; } r -= I_OB;
        if (r < I_O) { const int nb = DM / 32, kb = r / nb, n0 = 32 * (r % nb); fast_wt_item(p.in[I_WO] + (size_t)l * DM * DM, DM, DM, wsp<bf16>(p, WS_WTO) + (size_t)l * DM * DM, 64 * kb, n0, n0 + (lane & 31), scr, lane); continue; } r -= I_O;
        if (r < I_FO) { const int nb = DM / 32, kb = r / nb, n0 = 32 * (r % nb); fast_wt_item(p.in[I_FWO] + (size_t)l * DFF * DM, DFF, DM, wsp<bf16>(p, WS_WTFO) + (size_t)l * DM * DFF, 64 * kb, n0, n0 + (lane & 31), scr, lane); continue; } r -= I_FO;
        { const int em = r / 32, rr = r % 32, kb = rr / 2, n0 = 32 * (rr % 2);
            fast_wt_item(p.in[I_CW1] + ((size_t)(l * 2 + (em >> 1)) * 2048 + (em & 1) * 1024) * 64, 1024, 64, wsp<bf16>(p, WS_W1T) + ((size_t)(l * 2 + (em >> 1)) * 128 + (em & 1) * 64) * 1024, 64 * kb, n0, n0 + (lane & 31), scr, lane); }
    }
}

__device__ __forceinline__ void fast_cb(const Params& p, LAS unsigned char* lds, int wave, int lane) {
    for (int le = (int)gridDim.x - 1 - (int)blockIdx.x; le >= 0 && le < 4; le += gridDim.x) {
        const float* pos = p.in[I_CPOS] + (long)le * 2048 + wave * 256; const float* w1 = p.in[I_CW1] + ((long)le * 2048 + wave * 256) * 64 + lane; float acc = 0.f;
#pragma unroll 16
        for (int k = 0; k < 256; ++k) acc += pos[k] * w1[(long)k * 64];
        LAS float* part = (LAS float*)lds; part[wave * 64 + lane] = acc;
        __syncthreads();
        if (wave == 0) { float s2 = 0.f;
#pragma unroll
            for (int w8 = 0; w8 < 8; ++w8) s2 += part[w8 * 64 + lane];
            wsp<float>(p, WS_CB)[le * 64 + lane] = s2; }
        __syncthreads();
    }
}

__device__ __forceinline__ void up8(const u32x4 w, float* f) {
#pragma unroll
    for (int k = 0; k < 4; ++k) { f[2 * k] = __builtin_bit_cast(float, w[k] << 16); f[2 * k + 1] = __builtin_bit_cast(float, w[k] & 0xffff0000u); } }
struct ConvIn { u32x4 a0, a1, a2, fb; };
struct ConvW { f32x4 c0[2], c1[2], c2[2], cb[2]; };
__device__ __forceinline__ void conv8_load(const Params& p, long item, ConvIn& ci) {
    const int m = (int)(item / (DFF / 8)), col = (int)(item % (DFF / 8)) * 8; const RowInfo ri = rowinfo(m);
    const bf16* fa = wsp<bf16>(p, WS_FA) + (long)m * DFF + col;
    ci.a0 = *(const u32x4*)fa; ci.fb = *(const u32x4*)(wsp<bf16>(p, WS_FB) + (long)m * DFF + col);
    ci.a1 = ri.t >= 1 ? *(const u32x4*)(fa - DFF) : (u32x4){0u, 0u, 0u, 0u}; ci.a2 = ri.t >= 2 ? *(const u32x4*)(fa - 2 * DFF) : (u32x4){0u, 0u, 0u, 0u};
}
__device__ __forceinline__ void conv8_finish(const Params& p, int l, long item, const ConvIn& ci, const ConvW& w) {
    const int m = (int)(item / (DFF / 8)), col = (int)(item % (DFF / 8)) * 8; const RowInfo ri = rowinfo(m);
    float a0[8], a1[8], a2[8], fb[8]; up8(ci.a0, a0); up8(ci.a1, a1); up8(ci.a2, a2); up8(ci.fb, fb);
    if (ri.kind == 1 && ri.t < 2) {
        const float* pv1 = p.in[I_SCONV] + (((long)l * DB + ri.b) * 2 + 1) * DFF + col; const float* pv2 = p.in[I_SCONV] + (((long)l * DB + ri.b) * 2 + ri.t) * DFF + col;
#pragma unroll
        for (int k = 0; k < 8; ++k) { if (ri.t < 1) a1[k] = pv1[k]; a2[k] = pv2[k]; } }
    float o[8];
#pragma unroll
    for (int k = 0; k < 8; ++k) { const float u = w.cb[k >> 2][k & 3] + a2[k] * w.c0[k >> 2][k & 3] + a1[k] * w.c1[k >> 2][k & 3] + a0[k] * w.c2[k >> 2][k & 3]; o[k] = geluf_(u) * fb[k]; }
    st8bf(wsp<bf16>(p, WS_G) + (long)m * DFF + col, o);
}
constexpr long CONV_Q = (long)MREAL * (DFF / 8) / 4;
static_assert(((long)MREAL * (DFF / 8)) % 4 == 0 && CONV_Q % (DFF / 8) == 0, "conv items in column-aligned quarters");
__device__ __forceinline__ void fast_conv8x4(const Params& p, int l, long i) {
    ConvW w; { const int col = (int)(i % (DFF / 8)) * 8; const float* cw = p.in[I_FCW] + (long)l * 3 * DFF + col; const float* cb = p.in[I_FCB] + l * DFF + col;
#pragma unroll
        for (int hh = 0; hh < 2; ++hh) { w.c0[hh] = *(const f32x4*)(cw + 4 * hh); w.c1[hh] = *(const f32x4*)(cw + DFF + 4 * hh); w.c2[hh] = *(const f32x4*)(cw + 2 * DFF + 4 * hh); w.cb[hh] = *(const f32x4*)(cb + 4 * hh); } }
    ConvIn c[4];
#pragma unroll
    for (int k = 0; k < 4; ++k) conv8_load(p, i + k * CONV_Q, c[k]);
#pragma unroll
    for (int k = 0; k < 4; ++k) conv8_finish(p, l, i + k * CONV_Q, c[k], w);
}

constexpr long CONVFIX_P = (long)NB * (T / 256 - 1) * 2 * (DFF / 8), CONVFIX_N = CONVFIX_P + (long)NS * (DFF / 8);
__device__ __forceinline__ void fast_convfix(const Params& p, int l, long i) {
    long item;
    if (i < CONVFIX_P) { const long cg = i % (DFF / 8), r = i / (DFF / 8); const int rr = (int)(r & 1), tj = (int)(r >> 1) % (T / 256 - 1), b = (int)((r >> 1) / (T / 256 - 1)); item = ((long)b * T + (tj + 1) * 256 + rr) * (DFF / 8) + cg; }
    else item = (long)BT * (DFF / 8) + (i - CONVFIX_P);
    ConvW w; { const int col = (int)(item % (DFF / 8)) * 8; const float* cw = p.in[I_FCW] + (long)l * 3 * DFF + col; const float* cb = p.in[I_FCB] + l * DFF + col;
#pragma unroll
        for (int hh = 0; hh < 2; ++hh) { w.c0[hh] = *(const f32x4*)(cw + 4 * hh); w.c1[hh] = *(const f32x4*)(cw + DFF + 4 * hh); w.c2[hh] = *(const f32x4*)(cw + 2 * DFF + 4 * hh); w.cb[hh] = *(const f32x4*)(cb + 4 * hh); } }
    ConvIn ci; conv8_load(p, item, ci); conv8_finish(p, l, item, ci, w);
}
__device__ __forceinline__ void fast_retOs_gn(const Params& p, int l, long item, int lane) {
    const int h = (int)(item % RH), sr = (int)(item / RH), b = sr / DS, t = sr % DS; const long m = BT + sr; const float lg = retlg(h);
    const bf16* qv = wsp<bf16>(p, WS_RQ) + m * 512 + h * RDK; const float q0 = bf2f(qv[lane]), q1 = bf2f(qv[64 + lane]);
    float o[4] = {0.f, 0.f, 0.f, 0.f};
    for (int e = 0; e <= t; ++e) { const long me = BT + b * DS + e; const bf16* kv = wsp<bf16>(p, WS_RK) + me * 512 + h * RDK; const float sdot = wave_sum(q0 * bf2f(kv[lane]) + q1 * bf2f(kv[64 + lane])) * expf((float)(t - e) * lg);
        const bf16* vv = wsp<bf16>(p, WS_RV) + me * DM + h * RDV;
#pragma unroll
        for (int k = 0; k < 4; ++k) o[k] += sdot * bf2f(vv[64 * k + lane]); }
    const float* S0 = p.in[I_SRET] + ((((long)l * DB + b) * RH + h) * RDK) * RDV; const float qd = expf((float)(t + 1) * lg); float o2[4] = {0.f, 0.f, 0.f, 0.f};
#pragma unroll 32
    for (int d = 0; d < RDK; ++d) { const float qq = bf2f(qv[d]);
#pragma unroll
        for (int k = 0; k < 4; ++k) o2[k] += qq * S0[(long)d * RDV + 64 * k + lane]; }
#pragma unroll
    for (int k = 0; k < 4; ++k) o[k] += o2[k] * qd;
    const float mu = wave_sum((o[0] + o[1]) + (o[2] + o[3])) * (1.f / RDV); float var = 0.f;
#pragma unroll
    for (int k = 0; k < 4; ++k) { o[k] -= mu; var += o[k] * o[k]; }
    const float rs = 1.f / sqrtf(wave_sum(var) * (1.f / RDV) + 1e-5f);
#pragma unroll
    for (int k = 0; k < 4; ++k) { const long off = m * DM + h * RDV + 64 * k + lane; wsp<bf16>(p, WS_RO)[off] = (bf16)f2bf(bf2f(wsp<bf16>(p, WS_SRG)[off]) * o[k] * rs * p.in[I_GNW][l * DM + h * RDV + 64 * k + lane]); }
}

__device__ __forceinline__ void fast_retS8(const Params& p, int l, long item) {
    const int j8 = (int)(item % (RDV / 8)) * 8, ii = (int)(item / (RDV / 8)) % RDK, h = (int)(item / ((RDV / 8) * RDK)) % RH, b = (int)(item / ((RDV / 8) * RDK * RH));
    const float sdec = expf((float)RC * retlg(h));
    const long base = ((((long)b * RH + h) * NCH) * RDK + ii) * RDV + j8; const long stepn = (long)RDK * RDV;
    u32x4 uu[NCH];
#pragma unroll
    for (int n = 0; n < NCH; ++n) uu[n] = *(const u32x4*)(wsp<bf16>(p, WS_RETU) + base + n * stepn);
    float S[8]; float z0 = 0.f; asm volatile("" : "+v"(z0));
#pragma unroll
    for (int k = 0; k < 8; ++k) S[k] = z0;
#pragma unroll
    for (int n = 0; n < NCH; ++n) { st8bf(wsp<bf16>(p, WS_RETS) + base + n * stepn, S); float f[8]; up8(uu[n], f);
#pragma unroll
        for (int k = 0; k < 8; ++k) S[k] = S[k] * sdec + f[k]; }
    float* o = p.out + O_RETP + ((((long)l * NB + b) * RH + h) * RDK + ii) * RDV + j8;
    *(f32x4*)o = (f32x4){S[0], S[1], S[2], S[3]}; *(f32x4*)(o + 4) = (f32x4){S[4], S[5], S[6], S[7]};
}
constexpr long RETSS_Q = (long)DB * RH * RDK * (RDV / 4) / 4;
static_assert(((long)DB * RH * RDK * (RDV / 4)) % 4 == 0, "retSs items in quarters");
__device__ __forceinline__ void fast_retSs4x4(const Params& p, int l, long i0) {
    f32x4 S[4]; float kk[4][DS]; unsigned long long vv[4][DS]; long idx[4];
#pragma unroll
    for (int u = 0; u < 4; ++u) { const long item = i0 + u * RETSS_Q;
        const int j4 = (int)(item % (RDV / 4)) * 4, ii = (int)(item / (RDV / 4)) % RDK, h = (int)(item / ((RDV / 4) * RDK)) % RH, b = (int)(item / ((RDV / 4) * RDK * RH));
        idx[u] = ((((long)l * DB + b) * RH + h) * RDK + ii) * RDV + j4; S[u] = *(const f32x4*)(p.in[I_SRET] + idx[u]);
#pragma unroll
        for (int c = 0; c < DS; ++c) { const long mc = BT + b * DS + c; kk[u][c] = bf2f(wsp<bf16>(p, WS_RK)[mc * 512 + h * RDK + ii]); vv[u][c] = *(const unsigned long long*)(wsp<bf16>(p, WS_RV) + mc * DM + h * RDV + j4); } }
#pragma unroll
    for (int u = 0; u < 4; ++u) { const long item = i0 + u * RETSS_Q; const int h = (int)(item / ((RDV / 4) * RDK)) % RH; const float lg = retlg(h);
        f32x4 Sv = S[u] * expf((float)DS * lg);
#pragma unroll
        for (int c = 0; c < DS; ++c) { const float kc = kk[u][c] * expf((float)(DS - 1 - c) * lg); const unsigned long long v2 = vv[u][c];
            Sv[0] += kc * __builtin_bit_cast(float, (unsigned)v2 << 16); Sv[1] += kc * __builtin_bit_cast(float, (unsigned)v2 & 0xffff0000u);
            Sv[2] += kc * __builtin_bit_cast(float, (unsigned)(v2 >> 32) << 16); Sv[3] += kc * __builtin_bit_cast(float, (unsigned)(v2 >> 32) & 0xffff0000u); }
        *(f32x4*)(p.out + O_RETS + idx[u]) = Sv; }
}
__device__ __forceinline__ void fast_copywin(const Params& p, long item) {
    constexpr long PER = 508L * 256 / 4, TOT = 2L * DB * PER, Q = TOT / 4;
    f32x4 v[4];
#pragma unroll
    for (int k = 0; k < 4; ++k) { const long gidx = item + k * Q; const long lb = gidx / PER, r = gidx % PER; v[k] = *(const f32x4*)(p.in[I_SWIN] + lb * 512 * 256 + 4 * 256 + 4 * r); }
#pragma unroll
    for (int k = 0; k < 4; ++k) { const long gidx = item + k * Q; const long lb = gidx / PER, r = gidx % PER; *(f32x4*)(p.out + O_WINS + lb * 512 * 256 + 4 * r) = v[k]; }
}
static_assert((2L * DB * 508 * 256 / 4) % 4 == 0, "copywin quarters");

__device__ __forceinline__ void retOs_block(const Params& p, int l, LAS unsigned char* lds) {
    static_assert(DS == 4 && RDK == 128 && RDV == 256, "retOs_block shape");
    int tid_ = threadIdx.x; asm volatile("" : "+v"(tid_));
    const int lane = tid_ & 63, wave = __builtin_amdgcn_readfirstlane(tid_ >> 6);
    LAS float* part = (LAS float*)lds;
    for (int task = (int)blockIdx.x; task < DB * RH * 2; task += (int)gridDim.x) {
        const int tp = task & 1, h = (task >> 1) % RH, b = (task >> 1) / RH; const float lg = retlg(h); const long m0 = BT + (long)b * DS;
        const float* S0 = p.in[I_SRET] + ((((long)l * DB + b) * RH + h) * RDK + 16 * wave) * RDV + lane;
        float sv[16][4];
#pragma unroll
        for (int d = 0; d < 16; ++d)
#pragma unroll
            for (int k = 0; k < 4; ++k) sv[d][k] = S0[(long)d * RDV + 64 * k];
        const float qmine = bf2f(wsp<bf16>(p, WS_RQ)[(m0 + 2 * tp + ((lane >> 4) & 1)) * 512 + h * RDK + 16 * wave + (lane & 15)]);
        int pt = -1, pe = 0;
        if (tp == 0) { if (wave < 3) { pt = wave == 0 ? 0 : 1; pe = wave == 2 ? 1 : 0; } }
        else { if (wave < 3) { pt = 2; pe = wave; } else if (wave < 7) { pt = 3; pe = wave - 3; } }
        float o0[4] = {0.f, 0.f, 0.f, 0.f}, o1[4] = {0.f, 0.f, 0.f, 0.f};
        if (pt >= 0) { const bf16* qv = wsp<bf16>(p, WS_RQ) + (m0 + pt) * 512 + h * RDK; const bf16* kv = wsp<bf16>(p, WS_RK) + (m0 + pe) * 512 + h * RDK;
            const float sdot = wave_sum(bf2f(qv[lane]) * bf2f(kv[lane]) + bf2f(qv[64 + lane]) * bf2f(kv[64 + lane])) * expf((float)(pt - pe) * lg);
            const bf16* vv = wsp<bf16>(p, WS_RV) + (m0 + pe) * DM + h * RDV; const float c0 = (pt & 1) ? 0.f : sdot, c1 = (pt & 1) ? sdot : 0.f;
#pragma unroll
            for (int k = 0; k < 4; ++k) { const float vk = bf2f(vv[64 * k + lane]); o0[k] = c0 * vk; o1[k] = c1 * vk; } }
        float a0[4] = {0.f, 0.f, 0.f, 0.f}, a1[4] = {0.f, 0.f, 0.f, 0.f};
#pragma unroll
        for (int d = 0; d < 16; ++d) { const float q0 = __builtin_bit_cast(float, __builtin_amdgcn_readlane(__builtin_bit_cast(int, qmine), d)), q1 = __builtin_bit_cast(float, __builtin_amdgcn_readlane(__builtin_bit_cast(int, qmine), 16 + d));
#pragma unroll
            for (int k = 0; k < 4; ++k) { a0[k] += q0 * sv[d][k]; a1[k] += q1 * sv[d][k]; } }
        const float qd0 = expf((float)(2 * tp + 1) * lg), qd1 = expf((float)(2 * tp + 2) * lg);
#pragma unroll
        for (int k = 0; k < 4; ++k) { part[(wave * 2 + 0) * 256 + 64 * k + lane] = o0[k] + a0[k] * qd0; part[(wave * 2 + 1) * 256 + 64 * k + lane] = o1[k] + a1[k] * qd1; }
        const long m = m0 + 2 * tp + (wave & 1); float sg[4], gw[4];
        if (wave < 2) {
#pragma unroll
            for (int k = 0; k < 4; ++k) { sg[k] = bf2f(wsp<bf16>(p, WS_SRG)[m * DM + h * RDV + 64 * k + lane]); gw[k] = p.in[I_GNW][l * DM + h * RDV + 64 * k + lane]; } }
        __syncthreads();
        if (wave < 2) { float o[4];
#pragma unroll
            for (int k = 0; k < 4; ++k) { float acc = 0.f;
#pragma unroll
                for (int w = 0; w < 8; ++w) acc += part[(w * 2 + wave) * 256 + 64 * k + lane];
                o[k] = acc; }
            const float mu = wave_sum((o[0] + o[1]) + (o[2] + o[3])) * (1.f / RDV); float var = 0.f;
#pragma unroll
            for (int k = 0; k < 4; ++k) { o[k] -= mu; var += o[k] * o[k]; }
            const float rs = 1.f / sqrtf(wave_sum(var) * (1.f / RDV) + 1e-5f);
#pragma unroll
            for (int k = 0; k < 4; ++k) wsp<bf16>(p, WS_RO)[m * DM + h * RDV + 64 * k + lane] = (bf16)f2bf(sg[k] * o[k] * rs * gw[k]); }
        __syncthreads();
    }
}
__device__ __forceinline__ void fast_ada(const Params& p, LAS unsigned char* lds, int wave, int lane) {
    static_assert(NMODROW <= 40, "fast_ada row tiles");
    using fa::bf16x8; using fa::f32x16; using fa::cvtpk; using fa::crow;
    const int r32 = lane & 31, hi = lane >> 5;
    for (int slab = blockIdx.x; slab < 2 * 6144 / 64; slab += gridDim.x) {
        const int l = slab / 96, j0 = (slab % 96) * 64, k0 = wave * 128;
        LAS unsigned char* sl = lds + wave * 16384;
        { float cv[2][40];
#pragma unroll
          for (int r = 0; r < 40; ++r) if (r < NMODROW) { const float* c = (r < NB ? p.in[I_CP] + (long)r * DM : p.in[I_CS] + (long)(r - NB) * DM) + k0; cv[0][r] = c[lane]; cv[1][r] = c[64 + lane]; }
#pragma unroll
          for (int r = 0; r < 40; ++r) if (r < NMODROW) { *(LAS bf16*)(sl + r * 256 + lane * 2) = (bf16)f2bf(siluf_(cv[0][r])); *(LAS bf16*)(sl + r * 256 + (64 + lane) * 2) = (bf16)f2bf(siluf_(cv[1][r])); } }
        f32x16 acc[2][2];
#pragma unroll
        for (int rt = 0; rt < 2; ++rt)
#pragma unroll
            for (int ct = 0; ct < 2; ++ct)
#pragma unroll
                for (int r = 0; r < 16; ++r) acc[rt][ct][r] = 0.f;
        const float* w = p.in[I_ADAW] + ((long)l * DM + k0 + 8 * hi) * 6144 + j0 + r32;
        float wn[2][8];
#pragma unroll
        for (int ct = 0; ct < 2; ++ct)
#pragma unroll
            for (int e = 0; e < 8; ++e) wn[ct][e] = w[(long)e * 6144 + 32 * ct];
        asm volatile("s_waitcnt lgkmcnt(0)" ::: "memory");
#pragma unroll 1
        for (int ks = 0; ks < 8; ++ks) {
            bf16x8 bfr[2];
#pragma unroll
            for (int ct = 0; ct < 2; ++ct) { const u32x4 bw = (u32x4){cvtpk(wn[ct][0], wn[ct][1]), cvtpk(wn[ct][2], wn[ct][3]), cvtpk(wn[ct][4], wn[ct][5]), cvtpk(wn[ct][6], wn[ct][7])}; bfr[ct] = __builtin_bit_cast(bf16x8, bw); }
            if (ks + 1 < 8) {
#pragma unroll
                for (int ct = 0; ct < 2; ++ct)
#pragma unroll
                    for (int e = 0; e < 8; ++e) wn[ct][e] = w[(long)(16 * (ks + 1) + e) * 6144 + 32 * ct]; }
#pragma unroll
            for (int rt = 0; rt < 2; ++rt) { const bf16x8 af = *(const LAS bf16x8*)(sl + (32 * rt + r32) * 256 + (16 * ks + 8 * hi) * 2);
#pragma unroll
                for (int ct = 0; ct < 2; ++ct) acc[rt][ct] = __builtin_amdgcn_mfma_f32_32x32x16_bf16(af, bfr[ct], acc[rt][ct], 0, 0, 0); }
        }
        __syncthreads();
        LAS float* part = (LAS float*)lds;
#pragma unroll
        for (int rt = 0; rt < 2; ++rt)
#pragma unroll
            for (int ct = 0; ct < 2; ++ct)
#pragma unroll
                for (int r = 0; r < 16; ++r) { const int row = 32 * rt + crow(r, hi); if (row < NMODROW) part[(wave * NMODROW + row) * 64 + 32 * ct + r32] = acc[rt][ct][r]; }
        __syncthreads();
        for (int o = threadIdx.x; o < NMODROW * 64; o += NTHR_) { float sum = p.in[I_ADAB][l * 6144 + j0 + (o & 63)];
#pragma unroll
            for (int w8 = 0; w8 < 8; ++w8) sum += part[w8 * NMODROW * 64 + o];
            wsp<float>(p, WS_MOD)[((long)l * NMODROW + (o >> 6)) * 6144 + j0 + (o & 63)] = sum; }
        __syncthreads();
    }
}

#define XB_TMO      128
#define XB_XCNT(j)  (256  + 64 * (j))
#define XB_XSUB(j)  (1280 + 64 * (j))
#define XB_XGEN(j)  (2304 + 64 * (j))
#define XB_TOP      3328
#define XB_TOPGEN   3392
#define XCD_BAR_WORDS 3456
#define XB_SPIN_CAP (1u << 22)
__device__ __forceinline__ unsigned xb_ld(unsigned* p)              { return __hip_atomic_load(p, __ATOMIC_RELAXED, __HIP_MEMORY_SCOPE_AGENT); }
__device__ __forceinline__ unsigned xb_add(unsigned* p, unsigned v) { return __hip_atomic_fetch_add(p, v, __ATOMIC_RELAXED, __HIP_MEMORY_SCOPE_AGENT); }
__device__ __forceinline__ unsigned xb_xcc_id() { return (unsigned)__builtin_amdgcn_s_getreg((3 << 11) | 20) & 0xFu; }
#define XB_SPIN(cond, bar) do { unsigned _sp = 0; while (cond) { __builtin_amdgcn_s_sleep(1); \
    if ((++_sp & 255u) == 0u) { if (xb_ld(&(bar)[XB_TMO])) break; if (_sp > XB_SPIN_CAP) { atomicAdd(&(bar)[XB_TMO], 1u); break; } } } } while (0)
struct XcdBarrier { unsigned* bar; unsigned x; volatile LAS unsigned* st; };
__device__ __forceinline__ XcdBarrier xcd_barrier_post(unsigned* bar, volatile LAS unsigned* st) {
    XcdBarrier b; b.bar = bar; b.x = xb_xcc_id(); b.st = st;
    if (threadIdx.x == 0) (void)xb_add(&bar[XB_XCNT(b.x)], 1u);
    return b;
}
__device__ __forceinline__ void xcd_barrier_complete(unsigned* bar, unsigned x, unsigned& nloc, unsigned& nx) {
    const unsigned G = gridDim.x * gridDim.y * gridDim.z;
    unsigned sum, cnt, mine, sp = 0u;
    for (;;) {
        sum = 0u; cnt = 0u; mine = 0u;
#pragma unroll
        for (unsigned j = 0; j < 16; ++j) { const unsigned c = xb_ld(&bar[XB_XCNT(j)]); sum += c; cnt += (c > 0u) ? 1u : 0u; mine = (j == x) ? c : mine; }
        if (sum == G) break;
        __builtin_amdgcn_s_sleep(1);
        if ((++sp & 255u) == 0u) { if (xb_ld(&bar[XB_TMO])) break; if (sp > XB_SPIN_CAP) { atomicAdd(&bar[XB_TMO], 1u); break; } }
    }
    nloc = mine > 0u ? mine : 1u; nx = cnt > 0u ? cnt : 1u;
}
__device__ __forceinline__ void xcd_barrier(const XcdBarrier& b) {
    asm volatile("s_waitcnt vmcnt(0)" ::: "memory");
    __syncthreads();
    if (threadIdx.x == 0) {
        unsigned* bar = b.bar;
        __builtin_amdgcn_s_waitcnt(0);
        unsigned nloc = b.st[0], nx = b.st[1];
        if (nloc == 0u) { xcd_barrier_complete(bar, b.x, nloc, nx); b.st[0] = nloc; b.st[1] = nx; }
        const unsigned old = xb_add(&bar[XB_XSUB(b.x)], 1u);
        const unsigned gen = old / nloc;
        if (old + 1u == (gen + 1u) * nloc) {
            __builtin_amdgcn_fence(__ATOMIC_RELEASE, "agent");
            asm volatile("s_waitcnt vmcnt(0)" ::: "memory");
            const unsigned og = xb_add(&bar[XB_TOP], 1u);
            const unsigned tg = og / nx;
            if (og + 1u == (tg + 1u) * nx) xb_add(&bar[XB_TOPGEN], 1u);
            else XB_SPIN(xb_ld(&bar[XB_TOPGEN]) == tg, bar);
            __builtin_amdgcn_fence(__ATOMIC_ACQUIRE, "agent");
            xb_add(&bar[XB_XGEN(b.x)], 1u);
            asm volatile("s_waitcnt vmcnt(0)" ::: "memory");
        } else {
            XB_SPIN(xb_ld(&bar[XB_XGEN(b.x)]) == gen, bar);
            __builtin_amdgcn_fence(__ATOMIC_ACQUIRE, "agent");
            asm volatile("s_waitcnt vmcnt(0)" ::: "memory");
        }
    }
    __syncthreads();
}


constexpr int NSU = 4 * DB * 2;
__device__ __forceinline__ int umod(int a, int G) { return __builtin_amdgcn_readfirstlane(G == 256 ? (a & 255) : a % G); }
__device__ __forceinline__ int tail_early(int nunits, int G) { const int ex = umod(nunits, G); return ex == 0 ? 0 : G - ex; }
constexpr int FFN_TAIL_CAP = 136;
__device__ __forceinline__ int early_from_ffn(int l, int G) { if (l == 0) return 0; const int e = tail_early((MP / 256) * (NFI / 256), G); return e < FFN_TAIL_CAP ? e : FFN_TAIL_CAP; }
__device__ __forceinline__ int early_total(int l, int G) { const int e = early_from_ffn(l, G) + tail_early((MP / 256) * (NINP / 256), G); return e < NSU ? e : NSU; }

constexpr int NWAVES = 8, NTHR = NWAVES * 64;
constexpr int RING_OFF = 0, RING_BYTES = 131072, LDSCTL_OFF = RING_BYTES, MISC_OFF = LDSCTL_OFF + 320, LDS_BYTES = 147456;
#ifndef MK_ONE_LAUNCH
#define MK_ONE_LAUNCH 1
#endif
struct Args { Params p; int ph_lo, ph_hi; };
static_assert(sizeof(Args) == sizeof(Params) + 8, "no padding in Args");

#define LAUNDER_TID int _tid = threadIdx.x; asm volatile("" : "+v"(_tid))
#define RUNST(n_items, CALL) do { LAUNDER_TID; const long _n = (long)(n_items); for (long i = (long)blockIdx.x * NTHR + _tid; i < _n; i += (long)gridDim.x * NTHR) { CALL; } } while (0)
#define RUNSP(n_items, CALL) do { LAUNDER_TID; const long _n = (long)(n_items); \
    for (long c_ = (long)(_tid >> 6) * gridDim.x + blockIdx.x; c_ * 64 < _n; c_ += (long)gridDim.x * NWAVES) { const long i = c_ * 64 + (_tid & 63); if (i < _n) { CALL; } } } while (0)
#define RUNWV(n_rows, CALL) do { LAUNDER_TID; const int lane_ = _tid & 63; const long _n = (long)(n_rows); \
    for (long i = __builtin_amdgcn_readfirstlane((_tid >> 6) * (int)gridDim.x + (int)blockIdx.x); i < _n; i += (long)gridDim.x * NWAVES) { CALL; } } while (0)
#ifndef PROBE_MASK
#define PROBE_MASK 0
#endif
#ifndef FUSE_NORM
#define FUSE_NORM 0
#endif
#define REPS_CAT2(a, b) a##b
#define REPS_CAT(a, b) REPS_CAT2(a, b)
#define REPS(bit) for (int REPS_CAT(rep_, bit) = 0; REPS_CAT(rep_, bit) < (((PROBE_MASK) >> (bit)) & 1 ? 2 : 1); ++REPS_CAT(rep_, bit))
#define PHASE_PARAMS Params q = args.p; { long z_ = 0; asm volatile("" : "+s"(z_)); q.ws += z_; q.out += z_; }

__global__ void __launch_bounds__(NTHR, 2) mk_fwd(Args args) {
    extern __shared__ __attribute__((aligned(16))) unsigned char lds[];
    const Params& p = args.p;
    LAS unsigned char* ldsl = (LAS unsigned char*)lds;
    volatile LAS unsigned* MISC = (volatile LAS unsigned*)(ldsl + MISC_OFF);
    const int tid = threadIdx.x;
    for (int u = tid; u < (LDS_BYTES - LDSCTL_OFF) / 4; u += NTHR) ((LAS unsigned*)(ldsl + LDSCTL_OFF))[u] = 0u;
    __syncthreads();
    unsigned* ctl = (unsigned*)(p.ws + WS_CTL);
    XcdBarrier bar; bar.bar = ctl + 4096; bar.x = 0; bar.st = nullptr;
    if (MK_ONE_LAUNCH) bar = xcd_barrier_post(ctl + 4096, MISC + 8);
    const int lo = args.ph_lo, hi = args.ph_hi;
#define IN(k) (lo <= (k) && (k) < hi)
#define SEAM(k) do { if (MK_ONE_LAUNCH && IN(k) && IN((k) + 1)) { xcd_barrier(bar); if ((PROBE_MASK >> 12) & 1) xcd_barrier(bar); } } while (0)
    const int G = gridDim.x, bx = blockIdx.x;
    if (IN(0)) { PHASE_PARAMS;
        REPS(2) {
        REPS(13) { LAUNDER_TID; fast_prologue_weights(q, ldsl, (int)((_tid >> 6) * gridDim.x + blockIdx.x), (int)gridDim.x * NWAVES, _tid >> 6, _tid & 63); __syncthreads(); }
        REPS(14) { LAUNDER_TID; fast_ada(q, ldsl, _tid >> 6, _tid & 63); }
        REPS(15) {
        { LAUNDER_TID; fast_cb(q, ldsl, _tid >> 6, _tid & 63); }
        RUNST((long)NROTPOS * 64, st_rot(q, i));
        }
        }
    }
    SEAM(0);
    for (int l = 0; l < DEPTH; ++l) {
        const int pb = 1 + PH_PER_LAYER * l;
        if (l == 0 || !FUSE_NORM) { if (IN(pb + 0)) { PHASE_PARAMS; REPS(7) { RUNWV((MP + NORM_NR - 1) / NORM_NR, fast_norm_rows<NORM_NR>(q, l, 0, (int)i, lane_)); if (FUSE_NORM) RUNWV(sk::SHP_TASKS, sk::shp_task(q, (int)i, lane_)); } }
        SEAM(pb + 0); }
        if (IN(pb + 1)) { PHASE_PARAMS; REPS(0) { pg8::Gemm g{wsp<bf16>(q, WS_XN), wsp<bf16>(q, WS_WTIN) + (size_t)l * NINP * DM, MP, NINP, DM}; pg8::StaticOrder S; S.init(MP, NINP, G, bx);
            EpiInProj E{q, l, (FUSE_NORM && l > 0) ? 1 : 0}; pg8::gemm_phase<EpiInProj, pg8::StaticOrder, true, true>(ldsl + RING_OFF, g, S, E);  }
            { const int ex = umod((MP / 256) * (NINP / 256), G); const int k = early_from_ffn(l, G) + (bx - ex); if (ex != 0 && bx >= ex && k < early_total(l, G)) cp::cmp_unit(q, l, 2 * NB + k, ldsl + RING_OFF); } }
        SEAM(pb + 1);
        if (IN(pb + 2)) { PHASE_PARAMS; REPS(3) { const int first = early_total(l, G), R = 2 * NB + (NSU - first);
            for (int it = bx; it < R; it += G) cp::cmp_unit(q, l, it < 2 * NB ? it : 2 * NB + first + (it - 2 * NB), ldsl + RING_OFF);
            { const int nbusy = R < G ? R : G, nidle = G - nbusy, NU = NB * RH * NCH;
              const bool allidle = nidle >= 64; const int u0 = allidle ? (bx < nbusy ? NU : bx - nbusy) : bx, us = nidle == 0 ? G : (bx < nbusy ? NU : nidle);
              for (int u = u0; u < NU; u += us) rt::retU_unit(q, u, ldsl + RING_OFF);
              if (l == DEPTH - 1) { LAUNDER_TID; const int cb0 = nidle >= 64 ? nbusy : 0, cnb = nidle >= 64 ? nidle : G;
                  if (bx >= cb0) for (long i = (long)(bx - cb0) * NTHR + _tid; i < 2L * DB * 508 * 256 / 16; i += (long)cnb * NTHR) fast_copywin(q, i); } } } }
        SEAM(pb + 2);
        if (IN(pb + 3)) { PHASE_PARAMS; REPS(6) { { LAUNDER_TID; cp::cmp_fin_mfma(q, l, __builtin_amdgcn_readfirstlane((_tid >> 6) * (int)gridDim.x + (int)blockIdx.x), (int)gridDim.x * NWAVES, _tid & 63, __builtin_amdgcn_readfirstlane(_tid >> 6), ldsl + RING_OFF); } RUNST((long)NB * RH * RDK * (RDV / 8), fast_retS8(q, l, i)); } }
        SEAM(pb + 3);
        if (IN(pb + 4)) { PHASE_PARAMS; REPS(1) { REPS(9) { fa::attn_prompt_phase(q, ldsl + RING_OFF); }
            const bool alg = (G == NB * 32) && (DB * 2 == NB * 8); const int vcu_ = (bx % 8) * (G / 8) + bx / 8, s_ = vcu_ % 16, bg_ = vcu_ / 16;
            const int su0 = alg ? (s_ < 4 ? bg_ * 4 + s_ : DB * 2) : bx, sus = alg ? DB * 2 : G;
            REPS(10) { for (int u = su0; u < DB * 2; u += sus) sa::attn_sample_unit(q, l, u >> 1, u & 1, ldsl + RING_OFF); }
            { const int G2 = alg ? G - DB * 2 : (G > 2 * DB * 2 ? G - DB * 2 : G), b2 = alg ? (s_ < 4 ? -1 : bg_ * 12 + (s_ - 4)) : (G > 2 * DB * 2 ? bx - DB * 2 : bx);
              REPS(11) { if (b2 >= 0 && b2 < NB * RH * NCH) { u32x4 pq[4], ps[8]; { LAUNDER_TID; rt::retO_fetch(q, b2, _tid, pq, ps); }
                  for (int u = b2; u < NB * RH * NCH; u += G2) { const int un = u + G2 < NB * RH * NCH ? u + G2 : -1; rt::retO_unit(q, l, u, un, pq, ps, ldsl + RING_OFF); } } } }
            retOs_block(q, l, ldsl + RING_OFF); RUNST(RETSS_Q, fast_retSs4x4(q, l, i)); } }
        SEAM(pb + 4);
        if (IN(pb + 9)) { PHASE_PARAMS; REPS(5) { { pg8::Gemm g{wsp<bf16>(q, WS_OA), wsp<bf16>(q, WS_WTOA) + (size_t)l * DM * 512, BT, DM, 512}; pg8::StaticOrder S; S.init(BT, DM, G, bx);
            EpiMixA E{q}; pg8::gemm_phase<EpiMixA, pg8::StaticOrder, true, true>(ldsl + RING_OFF, g, S, E); }
            { pg8::Gemm g{wsp<bf16>(q, WS_RO), wsp<bf16>(q, WS_WTOB) + (size_t)l * DM * DM, BT, DM, DM}; pg8::StaticOrder S; S.init(BT, DM, G, bx);
            EpiMixB E{q}; pg8::gemm_phase<EpiMixB, pg8::StaticOrder, true, true>(ldsl + RING_OFF, g, S, E); } }
            for (int t = blockIdx.x; t < sk::NT; t += gridDim.x) sk::mix_tile(q, l, t, ldsl + RING_OFF); }
        SEAM(pb + 9);
        if (IN(pb + 11)) { PHASE_PARAMS; pg8::Gemm g{wsp<bf16>(q, WS_MIX), wsp<bf16>(q, WS_WTO) + (size_t)l * DM * DM, BT, DM, DM}; pg8::StaticOrder S; S.init(BT, DM, G, bx);
            EpiResid E{q, l, 2048, FUSE_NORM ? 0 : -1, l == 0 ? 1 : 0}; pg8::gemm_phase<EpiResid, pg8::StaticOrder, true, true>(ldsl + RING_OFF, g, S, E);
            for (int t = blockIdx.x; t < sk::NT; t += gridDim.x) sk::resid_tile(q, l, wsp<bf16>(q, WS_MIX), wsp<bf16>(q, WS_WTO) + (size_t)l * DM * DM, DM, 2048, FUSE_NORM ? 0 : -1, l == 0 ? 1 : 0, t, ldsl + RING_OFF); }
        SEAM(pb + 11);
        if (!FUSE_NORM) { if (IN(pb + 12)) { PHASE_PARAMS; REPS(7) { RUNWV((MP + NORM_NR - 1) / NORM_NR, fast_norm_rows<NORM_NR>(q, l, 1, (int)i, lane_)); } }
        SEAM(pb + 12); }
        if (IN(pb + 13)) { PHASE_PARAMS; REPS(4) { pg8::Gemm g{wsp<bf16>(q, WS_XN), wsp<bf16>(q, WS_WTFI) + (size_t)l * NFI * DM, MP, NFI, DM}; pg8::StaticOrder S; S.init(MP, NFI, G, bx);
            EpiFfnIn E{q, l, FUSE_NORM}; pg8::gemm_phase<EpiFfnIn, pg8::StaticOrder, true, true>(ldsl + RING_OFF, g, S, E);  }
            if (l + 1 < DEPTH) { const int ex = umod((MP / 256) * (NFI / 256), G); const int k = bx - ex; if (ex != 0 && bx >= ex && k < early_from_ffn(l + 1, G)) cp::cmp_unit(q, l + 1, 2 * NB + k, ldsl + RING_OFF); } }
        SEAM(pb + 13);
        if (IN(pb + 14)) { PHASE_PARAMS; REPS(8) { RUNST(CONVFIX_N, fast_convfix(q, l, i));  } }
        SEAM(pb + 14);
        if (IN(pb + 15)) { PHASE_PARAMS; pg8::Gemm g{wsp<bf16>(q, WS_G), wsp<bf16>(q, WS_WTFO) + (size_t)l * DM * DFF, BT, DM, DFF}; pg8::StaticOrder S; S.init(BT, DM, G, bx);
            EpiResid E{q, l, 5120, (FUSE_NORM && l + 1 < DEPTH) ? 1 : -1}; pg8::gemm_phase<EpiResid, pg8::StaticOrder, true, true>(ldsl + RING_OFF, g, S, E);
            for (int t = blockIdx.x; t < sk::NT; t += gridDim.x) sk::resid_tile(q, l, wsp<bf16>(q, WS_G), wsp<bf16>(q, WS_WTFO) + (size_t)l * DM * DFF, DFF, 5120, (FUSE_NORM && l + 1 < DEPTH) ? 1 : -1, 0, t, ldsl + RING_OFF); }
        SEAM(pb + 15);
    }
    if (IN(N_PHASES - 1)) { PHASE_PARAMS; RUNWV((MREAL + NORM_NR - 1) / NORM_NR, fast_norm_rows<NORM_NR>(q, 0, 2, (int)i, lane_)); }
#undef IN
#undef SEAM
}

extern "C" void kernel_launch(void* const* d_in, const int* in_sizes, int n_in, void* d_out, int out_size, void* d_ws, size_t ws_size, hipStream_t stream) {
    static int grid = 0;
    if (grid == 0) {
        if (n_in != 27 || out_size != (int)O_END || ws_size < WS_END) { fprintf(stderr, "kernel_launch: unexpected sizes n_in %d out %d (want %ld) ws %zu (want %zu)\n", n_in, out_size, (long)O_END, ws_size, (size_t)WS_END); grid = -1; return; }
        int dev = 0, cus = 0, per_cu = 0;
        if (hipGetDevice(&dev) != hipSuccess || hipDeviceGetAttribute(&cus, hipDeviceAttributeMultiprocessorCount, dev) != hipSuccess) { grid = -1; return; }
        if (hipFuncSetAttribute((const void*)mk_fwd, hipFuncAttributeMaxDynamicSharedMemorySize, LDS_BYTES) != hipSuccess) { fprintf(stderr, "kernel_launch: hipFuncSetAttribute failed\n"); grid = -1; return; }
        if (hipOccupancyMaxActiveBlocksPerMultiprocessor(&per_cu, (const void*)mk_fwd, NTHR, LDS_BYTES) != hipSuccess || per_cu < 1) fprintf(stderr, "kernel_launch: occupancy query says %d\n", per_cu);
        (void)hipGetLastError();
        grid = cus;
    }
    if (grid < 0) return;
    (void)hipMemsetAsync((char*)d_ws + WS_CTL, 0, CTL_ZERO_BYTES, stream);
    Args a{};
    for (int i = 0; i < 27; ++i) a.p.in[i] = (const float*)d_in[i];
    a.p.out = (float*)d_out; a.p.ws = (unsigned char*)d_ws;
    if (MK_ONE_LAUNCH) { a.ph_lo = 0; a.ph_hi = N_PHASES; hipLaunchKernelGGL(mk_fwd, dim3(grid), dim3(NTHR), LDS_BYTES, stream, a); }
    else for (int ph = 0; ph < N_PHASES; ++ph) { a.ph_lo = ph; a.ph_hi = ph + 1; hipLaunchKernelGGL(mk_fwd, dim3(grid), dim3(NTHR), LDS_BYTES, stream, a); }
}
#endif
```
